# Optimizing an MI355X kernel written in HIP

```python
import math
import jax, jax.numpy as jnp
from jax import lax
import numpy as np

D_MODEL = 2048
BATCH = 1
SEQ = 8192
DEPTH = 2

ATTN_HEADS = 8
ATTN_HEAD_DIM = 128
ATTN_WIDTH = ATTN_HEADS * ATTN_HEAD_DIM
MOBA_BLOCK = 256
MOBA_TOPK = 3
Q_BLOCK = 128
REL_BUCKETS = 32
REL_MAX_DIST = 128
SSD_HEADS = 32
SSD_HEAD_DIM = 64
SSD_WIDTH = SSD_HEADS * SSD_HEAD_DIM
SSD_GROUPS = 4
SSD_STATE = 128
SSD_CONV = 4
SSD_CHUNK = 256
SSD_XBC = SSD_WIDTH + 2 * SSD_GROUPS * SSD_STATE
CONV_WIDTH = 1024
CONV_K = 3
FFN_HIDDEN = 5632
FFN_RESIDUAL = 0.5
N_SUBLAYERS = 3
SEQ_ALIGN = math.lcm(MOBA_BLOCK, SSD_CHUNK)
MIX_SIZES = (ATTN_WIDTH, ATTN_WIDTH, ATTN_WIDTH,
             SSD_WIDTH, SSD_XBC, SSD_HEADS,
             CONV_WIDTH, CONV_WIDTH, CONV_WIDTH,
             D_MODEL, D_MODEL, D_MODEL)
MIX_IN = sum(MIX_SIZES)
NORM_EPS = 1e-6
NEG_INF = -1e30

kernel_name = "hybrid_moba_ssd_shortconv_block"


def rms_norm(x, gain):
    xf = x.astype(jnp.float32)
    y = xf * lax.rsqrt(jnp.mean(xf * xf, axis=-1, keepdims=True) + NORM_EPS)
    return (y * gain.astype(jnp.float32)).astype(x.dtype)


def causal_depthwise_conv(x, w):
    width = w.shape[0]
    return lax.conv_general_dilated(
        x, w[:, None, :].astype(x.dtype), window_strides=(1,), padding=[(width - 1, 0)],
        dimension_numbers=('NWC', 'WIO', 'NWC'), feature_group_count=x.shape[-1])


def swiglu_ffn(h, w_in, w_out):
    gate, up = jnp.split(h @ w_in, 2, axis=-1)
    return (jax.nn.silu(gate) * up) @ w_out


def t5_causal_bucket(dist):
    n = jnp.maximum(dist, 0)
    max_exact = REL_BUCKETS // 2
    ratio = jnp.log(jnp.maximum(n, 1).astype(jnp.float32) / max_exact) / math.log(REL_MAX_DIST / max_exact)
    large = max_exact + (ratio * (REL_BUCKETS - max_exact)).astype(jnp.int32)
    large = jnp.minimum(large, REL_BUCKETS - 1)
    return jnp.where(n < max_exact, n, large)


def moba_attention(q, k, v, rel_bias):
    b, h, s, d = q.shape
    nb = s // MOBA_BLOCK
    n_sel = min(MOBA_TOPK, nb)
    nq = s // Q_BLOCK
    scale = d ** -0.5
    kb = k.reshape(b, h, nb, MOBA_BLOCK, d)
    vb = v.reshape(b, h, nb, MOBA_BLOCK, d)
    k_mean = jnp.mean(kb.astype(jnp.float32), axis=3).astype(k.dtype)
    q_blk = jnp.arange(s) // MOBA_BLOCK
    gate = jnp.einsum('bhsd,bhnd->bhsn', q, k_mean).astype(jnp.float32)
    past = jnp.arange(nb)[None, :] < q_blk[:, None]
    gate = jnp.where(past, gate, -jnp.inf)
    _, sel = lax.top_k(gate, n_sel)
    sel_valid = sel < q_blk[:, None]
    q_c = q.reshape(b, h, nq, Q_BLOCK, d).transpose(2, 0, 1, 3, 4)
    sel_c = sel.reshape(b, h, nq, Q_BLOCK, n_sel).transpose(2, 0, 1, 3, 4)
    valid_c = sel_valid.reshape(b, h, nq, Q_BLOCK, n_sel).transpose(2, 0, 1, 3, 4)
    table = rel_bias.T
    head_idx = jnp.arange(h)[None, :, None, None, None]
    gather_blocks = jax.vmap(jax.vmap(lambda blocks, idx: blocks[idx]))

    def one_query_block(args):
        ci, qb, selb, validb = args
        q_pos = ci * Q_BLOCK + jnp.arange(Q_BLOCK)
        own = (ci * Q_BLOCK) // MOBA_BLOCK
        own_pos = own * MOBA_BLOCK + jnp.arange(MOBA_BLOCK)
        k_own = lax.dynamic_index_in_dim(kb, own, axis=2, keepdims=False)
        v_own = lax.dynamic_index_in_dim(vb, own, axis=2, keepdims=False)
        k_sel = gather_blocks(kb, selb)
        v_sel = gather_blocks(vb, selb)
        sel_pos = selb[..., None] * MOBA_BLOCK + jnp.arange(MOBA_BLOCK)
        bias_sel = table[head_idx, t5_causal_bucket(q_pos[:, None, None] - sel_pos)]
        l_sel = jnp.einsum('bhqd,bhqjkd->bhqjk', qb, k_sel).astype(jnp.float32) * scale + bias_sel
        l_sel = jnp.where(validb[..., None], l_sel, NEG_INF)
        bias_own = table[:, t5_causal_bucket(q_pos[:, None] - own_pos[None, :])]
        l_own = jnp.einsum('bhqd,bhkd->bhqk', qb, k_own).astype(jnp.float32) * scale + bias_own
        l_own = jnp.where(own_pos[None, :] <= q_pos[:, None], l_own, NEG_INF)
        logits = jnp.concatenate([l_sel.reshape(b, h, Q_BLOCK, n_sel * MOBA_BLOCK), l_own], axis=-1)
        p = jax.nn.softmax(logits, axis=-1)
        p_sel = p[..., :n_sel * MOBA_BLOCK].reshape(b, h, Q_BLOCK, n_sel, MOBA_BLOCK).astype(v.dtype)
        p_own = p[..., n_sel * MOBA_BLOCK:].astype(v.dtype)
        return (jnp.einsum('bhqjk,bhqjkd->bhqd', p_sel, v_sel)
                + jnp.einsum('bhqk,bhkd->bhqd', p_own, v_own))

    out = lax.map(one_query_block, (jnp.arange(nq), q_c, sel_c, valid_c))
    return out.transpose(1, 2, 0, 3, 4).reshape(b, h, s, d)


def ssd_chunked_scan(xs, dt, a, bm, cm):
    b, s = xs.shape[0], xs.shape[1]
    nc = s // SSD_CHUNK
    r = SSD_HEADS // SSD_GROUPS
    f32 = jnp.float32
    xd = (xs * dt[..., None]).reshape(b, nc, SSD_CHUNK, SSD_GROUPS, r, SSD_HEAD_DIM)
    ad = (dt.astype(f32) * a.astype(f32)).reshape(b, nc, SSD_CHUNK, SSD_GROUPS, r).transpose(0, 3, 4, 1, 2)
    bc = bm.reshape(b, nc, SSD_CHUNK, SSD_GROUPS, SSD_STATE)
    cc = cm.reshape(b, nc, SSD_CHUNK, SSD_GROUPS, SSD_STATE)
    a_cs = jnp.cumsum(ad, axis=-1)
    causal = jnp.tril(jnp.ones((SSD_CHUNK, SSD_CHUNK), dtype=bool))
    decay = jnp.exp(jnp.where(causal, a_cs[..., :, None] - a_cs[..., None, :], -jnp.inf))
    cb = jnp.einsum('bclgn,bcsgn->bgcls', cc, bc)
    y_diag = jnp.einsum('bgrcls,bcsgrp->bclgrp', cb[:, :, None] * decay, xd)
    decay_to_end = jnp.exp(a_cs[..., -1:] - a_cs)
    states = jnp.einsum('bclgn,bgrcl,bclgrp->cbgrpn', bc, decay_to_end, xd)
    chunk_decay = jnp.exp(a_cs[..., -1]).transpose(3, 0, 1, 2)

    def carry_state(hstate, inp):
        st, dec = inp
        return dec[..., None, None] * hstate + st, hstate

    h0 = jnp.zeros(states.shape[1:], states.dtype)
    _, prev = lax.scan(carry_state, h0, (states, chunk_decay))
    y_off = jnp.einsum('bclgn,cbgrpn,bgrcl->bclgrp', cc, prev, jnp.exp(a_cs))
    return (y_diag + y_off).reshape(b, s, SSD_HEADS, SSD_HEAD_DIM).astype(xs.dtype)


def token_mix(h, w_mix_in, qk_norm, rel_bias, w_ssd_conv, b_ssd_conv, ssd_dt_bias, ssd_a_log,
              ssd_d, ssd_norm, w_sc_conv, w_br_attn, w_br_ssd, w_br_conv, w_mix_out):
    b, s, _ = h.shape
    s_pad = -(-s // SEQ_ALIGN) * SEQ_ALIGN
    hp = jnp.pad(h, ((0, 0), (0, s_pad - s), (0, 0)))
    splits = [int(v) for v in np.cumsum(MIX_SIZES)[:-1]]
    (q, k, v, z, xbc, dt, conv_b, conv_c, conv_x,
     g_attn, g_ssd, g_conv) = jnp.split(hp @ w_mix_in, splits, axis=-1)

    def heads(t):
        return t.reshape(b, s_pad, ATTN_HEADS, ATTN_HEAD_DIM)
    qh = rms_norm(heads(q), qk_norm[0]).transpose(0, 2, 1, 3)
    kh = rms_norm(heads(k), qk_norm[1]).transpose(0, 2, 1, 3)
    vh = heads(v).transpose(0, 2, 1, 3)
    y_attn = moba_attention(qh, kh, vh, rel_bias).transpose(0, 2, 1, 3).reshape(b, s_pad, ATTN_WIDTH)

    xbc = jax.nn.silu(causal_depthwise_conv(xbc, w_ssd_conv) + b_ssd_conv)
    xs, bm, cm = jnp.split(xbc, [SSD_WIDTH, SSD_WIDTH + SSD_GROUPS * SSD_STATE], axis=-1)
    xs = xs.reshape(b, s_pad, SSD_HEADS, SSD_HEAD_DIM)
    dt = jax.nn.softplus(dt + ssd_dt_bias)
    a = -jnp.exp(ssd_a_log)
    y = ssd_chunked_scan(xs, dt, a, bm.reshape(b, s_pad, SSD_GROUPS, SSD_STATE),
                         cm.reshape(b, s_pad, SSD_GROUPS, SSD_STATE))
    y = (y + xs * ssd_d[:, None]).reshape(b, s_pad, SSD_WIDTH) * jax.nn.silu(z)
    group_w = SSD_WIDTH // SSD_GROUPS
    y_ssd = rms_norm(y.reshape(b, s_pad, SSD_GROUPS, group_w),
                     ssd_norm.reshape(SSD_GROUPS, group_w)).reshape(b, s_pad, SSD_WIDTH)

    y_conv = conv_b * causal_depthwise_conv(conv_c * conv_x, w_sc_conv)

    merged = (jax.nn.sigmoid(g_attn) * (y_attn @ w_br_attn)
              + jax.nn.sigmoid(g_ssd) * (y_ssd @ w_br_ssd)
              + jax.nn.sigmoid(g_conv) * (y_conv @ w_br_conv))
    return (merged @ w_mix_out)[:, :s]


def setup_inputs(seed: int = 0) -> dict:
    key = jax.random.key(seed)
    ks = jax.random.split(key, 24)
    f32 = jnp.float32

    def dense(k, shape, fan_in):
        return jax.random.normal(k, shape, f32) * fan_in ** -0.5

    def near_one(k, shape):
        return 1.0 + 0.1 * jax.random.normal(k, shape, f32)

    dt0 = jnp.exp(jax.random.uniform(ks[12], (DEPTH, SSD_HEADS), f32, math.log(1e-3), math.log(1e-1)))
    return {
        'x': jax.random.normal(ks[0], (BATCH, SEQ, D_MODEL), f32),
        'c': jax.random.normal(ks[1], (BATCH, D_MODEL), f32),
        'w_ada': dense(ks[2], (DEPTH, D_MODEL, N_SUBLAYERS * 3 * D_MODEL), D_MODEL),
        'b_ada': 0.02 * jax.random.normal(ks[3], (DEPTH, N_SUBLAYERS * 3 * D_MODEL), f32),
        'norm_gain': near_one(ks[4], (DEPTH, N_SUBLAYERS, D_MODEL)),
        'w_ffn_in': dense(ks[5], (DEPTH, 2, D_MODEL, 2 * FFN_HIDDEN), D_MODEL),
        'w_ffn_out': dense(ks[6], (DEPTH, 2, FFN_HIDDEN, D_MODEL), FFN_HIDDEN),
        'w_mix_in': dense(ks[7], (DEPTH, D_MODEL, MIX_IN), D_MODEL),
        'qk_norm': near_one(ks[8], (DEPTH, 2, ATTN_HEAD_DIM)),
        'rel_bias': 0.5 * jax.random.normal(ks[9], (REL_BUCKETS, ATTN_HEADS), f32),
        'w_ssd_conv': dense(ks[10], (DEPTH, SSD_CONV, SSD_XBC), SSD_CONV),
        'b_ssd_conv': 0.02 * jax.random.normal(ks[11], (DEPTH, SSD_XBC), f32),
        'ssd_dt_bias': dt0 + jnp.log(-jnp.expm1(-dt0)),
        'ssd_a_log': jnp.log(jax.random.uniform(ks[13], (DEPTH, SSD_HEADS), f32, 1.0, 16.0)),
        'ssd_d': near_one(ks[14], (DEPTH, SSD_HEADS)),
        'ssd_norm': near_one(ks[15], (DEPTH, SSD_WIDTH)),
        'w_sc_conv': dense(ks[16], (DEPTH, CONV_K, CONV_WIDTH), CONV_K),
        'w_br_attn': dense(ks[17], (DEPTH, ATTN_WIDTH, D_MODEL), ATTN_WIDTH),
        'w_br_ssd': dense(ks[18], (DEPTH, SSD_WIDTH, D_MODEL), SSD_WIDTH),
        'w_br_conv': dense(ks[19], (DEPTH, CONV_WIDTH, D_MODEL), CONV_WIDTH),
        'w_mix_out': dense(ks[20], (DEPTH, D_MODEL, D_MODEL), D_MODEL),
    }


def reference(x, c, w_ada, b_ada, norm_gain, w_ffn_in, w_ffn_out, w_mix_in, qk_norm, rel_bias,
              w_ssd_conv, b_ssd_conv, ssd_dt_bias, ssd_a_log, ssd_d, ssd_norm, w_sc_conv,
              w_br_attn, w_br_ssd, w_br_conv, w_mix_out):
    b = x.shape[0]
    cond = jax.nn.silu(c)
    for l in range(DEPTH):
        ada = (cond @ w_ada[l] + b_ada[l]).reshape(b, N_SUBLAYERS, 3, D_MODEL)
        shift, scale, gate = ada[:, :, 0, None], ada[:, :, 1, None], ada[:, :, 2, None]

        def modulated(t, i):
            return rms_norm(t, norm_gain[l, i]) * (1.0 + scale[:, i]) + shift[:, i]

        h = modulated(x, 0)
        x = x + FFN_RESIDUAL * gate[:, 0] * swiglu_ffn(h, w_ffn_in[l, 0], w_ffn_out[l, 0])
        h = modulated(x, 1)
        x = x + gate[:, 1] * token_mix(h, w_mix_in[l], qk_norm[l], rel_bias, w_ssd_conv[l], b_ssd_conv[l],
                                       ssd_dt_bias[l], ssd_a_log[l], ssd_d[l], ssd_norm[l], w_sc_conv[l],
                                       w_br_attn[l], w_br_ssd[l], w_br_conv[l], w_mix_out[l])
        h = modulated(x, 2)
        x = x + FFN_RESIDUAL * gate[:, 2] * swiglu_ffn(h, w_ffn_in[l, 1], w_ffn_out[l, 1])
    return x
```

```cpp
#include <hip/hip_runtime.h>
#include <cstdio>
#include <cstdint>
namespace pg8 {
#define PG8_LAS __attribute__((address_space(3)))
typedef unsigned short bf16_t;
typedef short bf16x8 __attribute__((ext_vector_type(8)));
typedef float f32x4 __attribute__((ext_vector_type(4)));
typedef unsigned u32x4 __attribute__((ext_vector_type(4)));
constexpr int BM = 256, BK = 64, HALF = 128, HTB = HALF * BK * 2  , STAGE_BYTES = 8 * HTB, NXCD = 8, WGM = 8;

__host__ __device__ __forceinline__ int lds_byte(int r, int c) { const int st = (r >> 4) * 2 + (c >> 5), rr = r & 15, cc = c & 31, ob = rr * 64 + cc * 2; return st * 1024 + (ob ^ (((ob >> 9) & 1) << 5)); }
__host__ __device__ __forceinline__ void stage_rc(int b, int& R, int& C) { const int st = b / 1024, sb = b % 1024, swz = sb ^ (((sb >> 9) & 1) << 5); R = (st >> 1) * 16 + swz / 64; C = (st & 1) * 32 + (swz % 64) / 2; }
__host__ __device__ __forceinline__ int perm32(int rho) { const int n = rho >> 4, i = rho & 15; return 8 * (i >> 2) + 4 * n + (i & 3); }

struct Unit { int pm, pn; };
struct Gemm { const bf16_t* A; const bf16_t* Bt; int M, N, K; };

struct StaticOrder {
    int nM, nN, nwg, G, c;
    __host__ __device__ void init(int M, int N, int G_, int c_) { nM = M / BM; nN = N / BM; nwg = nM * nN; G = G_; c = c_; }
    __host__ __device__ bool next(int i, Unit& u) const {
        const long L = (long)i * G + c; if (L >= nwg) return false;
        int wgid = (int)L; { const int q = nwg / NXCD, r = nwg % NXCD, xcd = wgid % NXCD, off = wgid / NXCD; wgid = (xcd < r ? xcd * (q + 1) : r * (q + 1) + (xcd - r) * q) + off; }
        const int nig = WGM * nN, gid = wgid / nig, fm = gid * WGM, gsz = (nM - fm) < WGM ? (nM - fm) : WGM;
        u.pm = fm + ((wgid % nig) % gsz); u.pn = (wgid % nig) / gsz; return true;
    }
    __device__ __forceinline__ void a_ready(const Unit&) const {}
    __device__ __forceinline__ void done(const Unit&) const {}
};

__device__ __forceinline__ unsigned cvt_pk_bf16(float lo, float hi) { unsigned r; asm volatile("v_cvt_pk_bf16_f32 %0, %1, %2" : "=v"(r) : "v"(lo), "v"(hi)); return r; }
typedef float f32x2 __attribute__((ext_vector_type(2)));
__device__ __forceinline__ float fast_sigmoid(float v) { return __builtin_amdgcn_rcpf(1.0f + __expf(-v)); }
__device__ __forceinline__ float fast_silu(float v) { return v * fast_sigmoid(v); }
__device__ __forceinline__ f32x4 unpack_lo(unsigned a, unsigned b) { return (f32x4){__uint_as_float(a << 16), __uint_as_float(a & 0xffff0000u), __uint_as_float(b << 16), __uint_as_float(b & 0xffff0000u)}; }
constexpr float NORM_EPS = 1e-6f;
__device__ __forceinline__ float row_rstd(const float* rsp, int r) {
    const f32x4* p = (const f32x4*)(rsp + (size_t)r * 32); float s = 0.f;
#pragma unroll
    for (int i = 0; i < 8; ++i) { const f32x4 v = p[i]; s += (v[0] + v[1]) + (v[2] + v[3]); }
    return rsqrtf(s * (1.0f / 2048.0f) + NORM_EPS);
}
struct EpiSwiGLU {
    static constexpr bool PERM = true, AFTER_DRAIN = false;
    bf16_t* O; const float* bias; const float* rowss; int ldo;
    __device__ __forceinline__ void operator()(const f32x4 (&acc)[2][2][4][2], const Unit& u, int wr, int wc, int fr_, int fq_) const {
        const int lane_ = (int)__builtin_amdgcn_mbcnt_hi(~0u, __builtin_amdgcn_mbcnt_lo(~0u, 0u)); const int fr = lane_ & 15, fq = lane_ >> 4; (void)fr_; (void)fq_;
        const int row0 = u.pm * BM + wr * 64 + fr, bcol0 = u.pn * BM + wc * 32 + 8 * fq, ocol0 = u.pn * HALF + wc * 32 + 8 * fq;
#pragma unroll
        for (int ai = 0; ai < 2; ++ai)
#pragma unroll
            for (int m = 0; m < 4; ++m) { const int r = row0 + ai * HALF + m * 16; const float rs = row_rstd(rowss, r);
                f32x4 h[2];
#pragma unroll
                for (int n = 0; n < 2; ++n) { const f32x4 g = acc[ai][0][m][n] * rs + *(const f32x4*)(bias + bcol0 + 4 * n), up = acc[ai][1][m][n] * rs + *(const f32x4*)(bias + bcol0 + HALF + 4 * n);
                    h[n] = (f32x4){fast_silu(g[0]) * up[0], fast_silu(g[1]) * up[1], fast_silu(g[2]) * up[2], fast_silu(g[3]) * up[3]}; }
                u32x4 w; w.x = cvt_pk_bf16(h[0][0], h[0][1]); w.y = cvt_pk_bf16(h[0][2], h[0][3]); w.z = cvt_pk_bf16(h[1][0], h[1][1]); w.w = cvt_pk_bf16(h[1][2], h[1][3]);
                *(u32x4*)(O + (size_t)r * ldo + ocol0) = w; }
    }
};
struct EpiResid {
    static constexpr bool PERM = true, AFTER_DRAIN = false;
    const float* xin; float* xout; bf16_t* xb; const float* gate; float wgt; float* rsp_next;
    __device__ __forceinline__ void operator()(const f32x4 (&acc)[2][2][4][2], const Unit& u, int wr, int wc, int fr_, int fq_) const {
        const int lane_ = (int)__builtin_amdgcn_mbcnt_hi(~0u, __builtin_amdgcn_mbcnt_lo(~0u, 0u)); const int fr = lane_ & 15, fq = lane_ >> 4; (void)fr_; (void)fq_;
        const int row0 = u.pm * BM + wr * 64 + fr, col0 = u.pn * BM + wc * 32 + 8 * fq;
        f32x4 gt[2][2];
#pragma unroll
        for (int bj = 0; bj < 2; ++bj)
#pragma unroll
            for (int n = 0; n < 2; ++n) gt[bj][n] = *(const f32x4*)(gate + col0 + bj * HALF + 4 * n) * wgt;
#pragma unroll
        for (int ai = 0; ai < 2; ++ai)
#pragma unroll
            for (int m = 0; m < 4; ++m) { const int r = row0 + ai * HALF + m * 16; float ss = 0.f;
#pragma unroll
                for (int bj = 0; bj < 2; ++bj) { const size_t off = (size_t)r * 2048 + col0 + bj * HALF;
                    f32x4 x0 = *(const f32x4*)(xin + off), x1 = *(const f32x4*)(xin + off + 4);
                    x0 = x0 + gt[bj][0] * acc[ai][bj][m][0]; x1 = x1 + gt[bj][1] * acc[ai][bj][m][1];
                    *(f32x4*)(xout + off) = x0; *(f32x4*)(xout + off + 4) = x1;
                    u32x4 w; w.x = cvt_pk_bf16(x0[0], x0[1]); w.y = cvt_pk_bf16(x0[2], x0[3]); w.z = cvt_pk_bf16(x1[0], x1[1]); w.w = cvt_pk_bf16(x1[2], x1[3]);
                    *(u32x4*)(xb + off) = w;
                    ss += (x0[0] * x0[0] + x0[1] * x0[1]) + (x0[2] * x0[2] + x0[3] * x0[3]) + (x1[0] * x1[0] + x1[1] * x1[1]) + (x1[2] * x1[2] + x1[3] * x1[3]); }
                ss += __shfl_xor(ss, 16); ss += __shfl_xor(ss, 32);
                if (rsp_next != nullptr && fq == 0) rsp_next[(size_t)r * 32 + u.pn * 4 + wc] = ss; }
    }
};
struct EpiMix {
    static constexpr bool PERM = true, AFTER_DRAIN = false;
    bf16_t* O; const float* bias; const float* rowss; int ldo; int sig_tile;
    __device__ __forceinline__ void operator()(const f32x4 (&acc)[2][2][4][2], const Unit& u, int wr, int wc, int fr_, int fq_) const {
        const int lane_ = (int)__builtin_amdgcn_mbcnt_hi(~0u, __builtin_amdgcn_mbcnt_lo(~0u, 0u)); const int fr = lane_ & 15, fq = lane_ >> 4; (void)fr_; (void)fq_;
        const int row0 = u.pm * BM + wr * 64 + fr, col0 = u.pn * BM + wc * 32 + 8 * fq; const bool sig = u.pn >= sig_tile;
        f32x4 bv[2][2];
#pragma unroll
        for (int bj = 0; bj < 2; ++bj)
#pragma unroll
            for (int n = 0; n < 2; ++n) bv[bj][n] = *(const f32x4*)(bias + col0 + bj * HALF + 4 * n);
#pragma unroll
        for (int ai = 0; ai < 2; ++ai)
#pragma unroll
            for (int m = 0; m < 4; ++m) { const int r = row0 + ai * HALF + m * 16; const float rs = row_rstd(rowss, r);
#pragma unroll
                for (int bj = 0; bj < 2; ++bj) { f32x4 v0 = acc[ai][bj][m][0] * rs + bv[bj][0], v1 = acc[ai][bj][m][1] * rs + bv[bj][1];
                    if (sig) { v0 = (f32x4){fast_sigmoid(v0[0]), fast_sigmoid(v0[1]), fast_sigmoid(v0[2]), fast_sigmoid(v0[3])}; v1 = (f32x4){fast_sigmoid(v1[0]), fast_sigmoid(v1[1]), fast_sigmoid(v1[2]), fast_sigmoid(v1[3])}; }
                    u32x4 w; w.x = cvt_pk_bf16(v0[0], v0[1]); w.y = cvt_pk_bf16(v0[2], v0[3]); w.z = cvt_pk_bf16(v1[0], v1[1]); w.w = cvt_pk_bf16(v1[2], v1[3]);
                    *(u32x4*)(O + (size_t)r * ldo + col0 + bj * HALF) = w; } }
    }
};
template <int P> struct EpiBr {
    static constexpr bool PERM = true, AFTER_DRAIN = false;
    const bf16_t* sg; int ldg; const float* prev; float* outf; bf16_t* outb;
    __device__ __forceinline__ void operator()(const f32x4 (&acc)[2][2][4][2], const Unit& u, int wr, int wc, int fr_, int fq_) const {
        const int lane_ = (int)__builtin_amdgcn_mbcnt_hi(~0u, __builtin_amdgcn_mbcnt_lo(~0u, 0u)); const int fr = lane_ & 15, fq = lane_ >> 4; (void)fr_; (void)fq_;
        const int row0 = u.pm * BM + wr * 64 + fr, col0 = u.pn * BM + wc * 32 + 8 * fq;
#pragma unroll
        for (int ai = 0; ai < 2; ++ai)
#pragma unroll
            for (int m = 0; m < 4; ++m) { const int r = row0 + ai * HALF + m * 16;
#pragma unroll
                for (int bj = 0; bj < 2; ++bj) { const size_t off = (size_t)r * 2048 + col0 + bj * HALF;
                    const u32x4 gw = *(const u32x4*)(sg + (size_t)r * ldg + col0 + bj * HALF);
                    f32x4 v0 = unpack_lo(gw.x, gw.y) * acc[ai][bj][m][0], v1 = unpack_lo(gw.z, gw.w) * acc[ai][bj][m][1];
                    if (P > 0) { v0 = v0 + *(const f32x4*)(prev + off); v1 = v1 + *(const f32x4*)(prev + off + 4); }
                    if (P < 2) { *(f32x4*)(outf + off) = v0; *(f32x4*)(outf + off + 4) = v1; }
                    else { u32x4 w; w.x = cvt_pk_bf16(v0[0], v0[1]); w.y = cvt_pk_bf16(v0[2], v0[3]); w.z = cvt_pk_bf16(v1[0], v1[1]); w.w = cvt_pk_bf16(v1[2], v1[3]); *(u32x4*)(outb + off) = w; } } }
    }
};

template <class Epi, class Sched, bool ALIGN_EPI = false, bool SP2 = false>
__device__ __forceinline__ void gemm_phase(PG8_LAS unsigned char* lds, const Gemm g, const Sched& S, const Epi& E) {
    int tid_ = threadIdx.x; asm volatile("" : "+v"(tid_));
    const int tid = tid_, wid = __builtin_amdgcn_readfirstlane(tid >> 6), lane = tid & 63, wr = wid >> 2, wc = wid & 3, fr = lane & 15, fq = lane >> 4;
    const int K = g.K, nt = K / BK;
    unsigned voffA[2], voffB[2];
#pragma unroll
    for (int i = 0; i < 2; ++i) { int R, C; stage_rc(tid * 16 + i * 8192, R, C); const int Rb = Epi::PERM ? ((R & ~31) + perm32(R & 31)) : R;
        voffA[i] = (unsigned)(R * K + C) * 2u; voffB[i] = (unsigned)(Rb * K + C) * 2u; }
    const size_t kstep = (size_t)(BK * 2);
    const size_t hstep = (size_t)HALF * K * 2;
    const size_t tstep = 2 * hstep;
    const unsigned ldsw = (unsigned)wid * 1024u;
    const int aoff = lds_byte(wr * 64 + fr, fq * 8), boff = lds_byte(wc * 32 + fr, fq * 8);
#define PG8_SA(b, h) (((b) * 2 + (h)) * HTB)
#define PG8_SB(b, h) ((4 + (b) * 2 + (h)) * HTB)
#define PG8_STAGE(bufoff, gbase, voff) do { _Pragma("unroll") for (int _i = 0; _i < 2; ++_i) \
        __builtin_amdgcn_global_load_lds((const unsigned*)((const char*)(gbase) + (voff)[_i]), (PG8_LAS unsigned*)(lds + (bufoff) + ldsw + _i * 8192), 16, 0, 0); } while (0)
#define PG8_LDA(dst, b, h) do { _Pragma("unroll") for (int m = 0; m < 4; ++m) _Pragma("unroll") for (int k = 0; k < 2; ++k) dst[m][k] = *(const PG8_LAS bf16x8*)(lds + PG8_SA(b, h) + aoff + m * 2048 + k * 1024); } while (0)
#define PG8_LDB(dst, b, h) do { _Pragma("unroll") for (int n = 0; n < 2; ++n) _Pragma("unroll") for (int k = 0; k < 2; ++k) dst[n][k] = *(const PG8_LAS bf16x8*)(lds + PG8_SB(b, h) + boff + n * 2048 + k * 1024); } while (0)
#define PG8_MMA(ai, bj, At, Bt) do { __builtin_amdgcn_s_setprio(1); _Pragma("unroll") for (int m = 0; m < 4; ++m) _Pragma("unroll") for (int n = 0; n < 2; ++n) _Pragma("unroll") for (int k = 0; k < 2; ++k) \
        acc[ai][bj][m][n] = __builtin_amdgcn_mfma_f32_16x16x32_bf16(Bt[n][k], At[m][k], acc[ai][bj][m][n], 0, 0, 0); __builtin_amdgcn_s_setprio(0); } while (0)
#define PG8_WAIT_V(n) asm volatile("s_waitcnt vmcnt(" #n ")" ::: "memory")
#define PG8_WAIT_L(n) asm volatile("s_waitcnt lgkmcnt(" #n ")" ::: "memory")
#define PG8_BAR __builtin_amdgcn_s_barrier()
#define PG8_SCHED __builtin_amdgcn_sched_barrier(0)
    Unit cur, nxt; int ui = 0;
    if (!S.next(0, cur)) return;
    f32x4 acc[2][2][4][2];
#pragma unroll
    for (int a = 0; a < 2; ++a)
#pragma unroll
        for (int b = 0; b < 2; ++b)
#pragma unroll
            for (int m = 0; m < 4; ++m)
#pragma unroll
                for (int n = 0; n < 2; ++n) acc[a][b][m][n] = (f32x4){0.f, 0.f, 0.f, 0.f};
    bf16x8 At[4][2], B0[2][2], B1[2][2];
    const char* cA = (const char*)g.A + (size_t)cur.pm * tstep; const char* cB = (const char*)g.Bt + (size_t)cur.pn * tstep;
    S.a_ready(cur);
    if constexpr (SP2) {
        PG8_STAGE(PG8_SB(0, 0), cB, voffB); PG8_STAGE(PG8_SB(0, 1), cB + hstep, voffB); PG8_STAGE(PG8_SA(0, 0), cA, voffA); PG8_STAGE(PG8_SA(0, 1), cA + hstep, voffA);
        if (wr == 1) PG8_BAR;
        PG8_WAIT_V(2); PG8_BAR;
        PG8_STAGE(PG8_SB(1, 0), cB + kstep, voffB); PG8_STAGE(PG8_SA(1, 0), cA + kstep, voffA); PG8_STAGE(PG8_SB(1, 1), cB + hstep + kstep, voffB);
        PG8_WAIT_V(6); PG8_BAR;
    } else {
        PG8_STAGE(PG8_SB(0, 0), cB, voffB); PG8_STAGE(PG8_SA(0, 0), cA, voffA); PG8_STAGE(PG8_SB(0, 1), cB + hstep, voffB); PG8_STAGE(PG8_SA(0, 1), cA + hstep, voffA);
        if (wr == 1) PG8_BAR;
        PG8_WAIT_V(4); PG8_BAR;
        PG8_STAGE(PG8_SB(1, 0), cB + kstep, voffB); PG8_STAGE(PG8_SA(1, 0), cA + kstep, voffA); PG8_STAGE(PG8_SB(1, 1), cB + hstep + kstep, voffB);
        PG8_WAIT_V(6); PG8_BAR;
    }
    for (;;) {
        const bool has_next = S.next(ui + 1, nxt);
        const char* nA = has_next ? (const char*)g.A + (size_t)nxt.pm * tstep : cA; const char* nB = has_next ? (const char*)g.Bt + (size_t)nxt.pn * tstep : cB;
        for (int t = 0; t < nt; t += 2) {
            const bool last = (t == nt - 2);
            const char* a1 = cA + (size_t)(t + 1) * kstep;
            const char* a2 = last ? nA : cA + (size_t)(t + 2) * kstep; const char* b2 = last ? nB : cB + (size_t)(t + 2) * kstep;
            const char* a3 = a2 + kstep; const char* b3 = b2 + kstep;
            if (last && has_next) S.a_ready(nxt);
            if constexpr (SP2) {
            PG8_LDB(B0, 0, 0); PG8_LDB(B1, 0, 1); PG8_SCHED; PG8_LDA(At, 0, 0); PG8_STAGE(PG8_SA(1, 1), a1 + hstep, voffA);
            PG8_WAIT_V(8); PG8_WAIT_L(0); PG8_BAR; PG8_MMA(0, 0, At, B0); PG8_MMA(0, 1, At, B1); PG8_BAR; PG8_SCHED;
            PG8_LDA(At, 0, 1); PG8_STAGE(PG8_SB(0, 0), b2, voffB); PG8_STAGE(PG8_SB(0, 1), b2 + hstep, voffB); PG8_STAGE(PG8_SA(0, 0), a2, voffA);
            PG8_WAIT_V(8); PG8_WAIT_L(0); PG8_BAR; PG8_MMA(1, 0, At, B0); PG8_MMA(1, 1, At, B1); PG8_BAR; PG8_SCHED;
            PG8_LDB(B0, 1, 0); PG8_LDB(B1, 1, 1); PG8_SCHED; PG8_LDA(At, 1, 0); PG8_STAGE(PG8_SA(0, 1), a2 + hstep, voffA);
            PG8_WAIT_V(8); PG8_WAIT_L(0); PG8_BAR; PG8_MMA(0, 0, At, B0); PG8_MMA(0, 1, At, B1); PG8_BAR; PG8_SCHED;
            PG8_LDA(At, 1, 1); PG8_STAGE(PG8_SB(1, 0), b3, voffB); PG8_STAGE(PG8_SB(1, 1), b3 + hstep, voffB); PG8_STAGE(PG8_SA(1, 0), a3, voffA);
            PG8_WAIT_V(8); PG8_WAIT_L(0); PG8_BAR; PG8_MMA(1, 0, At, B0); PG8_MMA(1, 1, At, B1); PG8_BAR; PG8_SCHED;
            } else {
            PG8_LDB(B0, 0, 0); PG8_SCHED; PG8_LDA(At, 0, 0); PG8_STAGE(PG8_SA(1, 1), a1 + hstep, voffA);
            PG8_WAIT_L(8); PG8_BAR; PG8_WAIT_L(0); PG8_MMA(0, 0, At, B0); PG8_BAR; PG8_SCHED;
            PG8_LDB(B1, 0, 1); PG8_STAGE(PG8_SB(0, 0), b2, voffB);
            PG8_BAR; PG8_WAIT_L(0); PG8_MMA(0, 1, At, B1); PG8_BAR;
            PG8_LDA(At, 0, 1); PG8_STAGE(PG8_SA(0, 0), a2, voffA);
            PG8_BAR; PG8_WAIT_L(0); PG8_MMA(1, 0, At, B0); PG8_BAR; PG8_SCHED;
            PG8_STAGE(PG8_SB(0, 1), b2 + hstep, voffB);
            PG8_WAIT_V(6); PG8_BAR; PG8_MMA(1, 1, At, B1); PG8_BAR;
            PG8_LDB(B0, 1, 0); PG8_SCHED; PG8_LDA(At, 1, 0); PG8_STAGE(PG8_SA(0, 1), a2 + hstep, voffA);
            PG8_WAIT_L(8); PG8_BAR; PG8_WAIT_L(0); PG8_MMA(0, 0, At, B0); PG8_BAR; PG8_SCHED;
            PG8_LDB(B1, 1, 1); PG8_STAGE(PG8_SB(1, 0), b3, voffB);
            PG8_BAR; PG8_WAIT_L(0); PG8_MMA(0, 1, At, B1); PG8_BAR;
            PG8_LDA(At, 1, 1); PG8_STAGE(PG8_SA(1, 0), a3, voffA);
            PG8_BAR; PG8_WAIT_L(0); PG8_MMA(1, 0, At, B0); PG8_BAR; PG8_SCHED;
            PG8_STAGE(PG8_SB(1, 1), b3 + hstep, voffB);
            PG8_WAIT_V(6); PG8_BAR; PG8_MMA(1, 1, At, B1); PG8_BAR;
            }
        }
        if constexpr (ALIGN_EPI) { if (wr == 0) PG8_BAR; }
        if constexpr (!Epi::AFTER_DRAIN) { E(acc, cur, wr, wc, fr, fq); S.done(cur); }
        if (!has_next) break;
#pragma unroll
        for (int a = 0; a < 2; ++a)
#pragma unroll
            for (int b = 0; b < 2; ++b)
#pragma unroll
                for (int m = 0; m < 4; ++m)
#pragma unroll
                    for (int n = 0; n < 2; ++n) acc[a][b][m][n] = (f32x4){0.f, 0.f, 0.f, 0.f};
        cur = nxt; cA = nA; cB = nB; ++ui;
        if constexpr (ALIGN_EPI) { if (wr == 1) PG8_BAR; }
    }
    PG8_WAIT_V(0);
    if constexpr (!ALIGN_EPI) { if (wr == 0) PG8_BAR; }
    PG8_BAR;
    if constexpr (Epi::AFTER_DRAIN) { E.fused(acc, cur, wr, wc, fr, fq, lds, wid, lane); S.done(cur); }
#undef PG8_SA
#undef PG8_SB
#undef PG8_STAGE
#undef PG8_LDA
#undef PG8_LDB
#undef PG8_MMA
#undef PG8_WAIT_V
#undef PG8_WAIT_L
#undef PG8_BAR
#undef PG8_SCHED
}
}

#define GAS __attribute__((address_space(1)))
#define LAS __attribute__((address_space(3)))
typedef unsigned short bf16;
typedef unsigned v4u __attribute__((ext_vector_type(4)));
typedef float f32x4 __attribute__((ext_vector_type(4)));
typedef short bf16x8 __attribute__((ext_vector_type(8)));
typedef GAS unsigned gu32;
typedef GAS unsigned long long gu64;
#define RLX_AGENT __ATOMIC_RELAXED, __HIP_MEMORY_SCOPE_AGENT
#define LDS_WAIT() asm volatile("s_waitcnt lgkmcnt(0)" ::: "memory")
#define VM_WAIT() asm volatile("s_waitcnt vmcnt(0)" ::: "memory")
__device__ __forceinline__ unsigned long long rt() { return __builtin_amdgcn_s_memrealtime(); }
__device__ __forceinline__ unsigned f2bf(float f) { unsigned u = __builtin_bit_cast(unsigned, f); return (u + 0x7fffu + ((u >> 16) & 1u)) >> 16; }
__device__ __forceinline__ unsigned pk2(float lo, float hi) { return f2bf(lo) | (f2bf(hi) << 16); }

#define XB_TMO      128
#define XB_XCNT(j)  (256  + 64 * (j))
#define XB_XSUB(j)  (1280 + 64 * (j))
#define XB_XGEN(j)  (2304 + 64 * (j))
#define XB_TOP      3328
#define XB_TOPGEN   3392
#define XCD_BAR_WORDS 3456
#define XB_SPIN_CAP (1u << 18)

__device__ __forceinline__ unsigned xb_ld(unsigned* p)              { return __hip_atomic_load(p, __ATOMIC_RELAXED, __HIP_MEMORY_SCOPE_AGENT); }
__device__ __forceinline__ unsigned xb_add(unsigned* p, unsigned v) { return __hip_atomic_fetch_add(p, v, __ATOMIC_RELAXED, __HIP_MEMORY_SCOPE_AGENT); }
__device__ __forceinline__ unsigned xb_xcc_id() { return (unsigned)__builtin_amdgcn_s_getreg((3 << 11) | 20) & 0xFu; }
#define XB_SPIN(cond, bar) do { unsigned _sp = 0; while (cond) { __builtin_amdgcn_s_sleep(1); \
    if ((++_sp & 255u) == 0u) { if (xb_ld(&(bar)[XB_TMO])) break; if (_sp > XB_SPIN_CAP) { atomicAdd(&(bar)[XB_TMO], 1u); break; } } } } while (0)

struct XcdBarrier {
    unsigned* bar; unsigned x;
    volatile LAS unsigned* st;
};

__device__ __forceinline__ XcdBarrier xcd_barrier_post(unsigned* bar, volatile LAS unsigned* st) {
    XcdBarrier b; b.bar = bar; b.x = xb_xcc_id(); b.st = st;
    if (threadIdx.x == 0) (void)xb_add(&bar[XB_XCNT(b.x)], 1u);
    return b;
}
__device__ __forceinline__ void xcd_barrier_complete(unsigned* bar, unsigned x, unsigned& nloc, unsigned& nx) {
    const unsigned G = gridDim.x * gridDim.y * gridDim.z;
    unsigned sum, cnt, mine, sp = 0u;
    for (;;) {
        sum = 0u; cnt = 0u; mine = 0u;
#pragma unroll
        for (unsigned j = 0; j < 16; ++j) { const unsigned c = xb_ld(&bar[XB_XCNT(j)]); sum += c; cnt += (c > 0u) ? 1u : 0u; mine = (j == x) ? c : mine; }
        if (sum == G) break;
        __builtin_amdgcn_s_sleep(1);
        if ((++sp & 255u) == 0u) { if (xb_ld(&bar[XB_TMO])) break; if (sp > XB_SPIN_CAP) { atomicAdd(&bar[XB_TMO], 1u); break; } }
    }
    nloc = mine > 0u ? mine : 1u; nx = cnt > 0u ? cnt : 1u;
}

__device__ __forceinline__ void xcd_barrier(const XcdBarrier& b) {
    asm volatile("s_waitcnt vmcnt(0)" ::: "memory");
    __syncthreads();
    if (threadIdx.x == 0) {
        unsigned* bar = b.bar;
        __builtin_amdgcn_s_waitcnt(0);
        unsigned nloc = b.st[0], nx = b.st[1];
        if (nloc == 0u) { xcd_barrier_complete(bar, b.x, nloc, nx); b.st[0] = nloc; b.st[1] = nx; }
        const unsigned old = xb_add(&bar[XB_XSUB(b.x)], 1u);
        const unsigned gen = old / nloc;
        if (old + 1u == (gen + 1u) * nloc) {
            __builtin_amdgcn_fence(__ATOMIC_RELEASE, "agent");
            asm volatile("s_waitcnt vmcnt(0)" ::: "memory");
            const unsigned og = xb_add(&bar[XB_TOP], 1u);
            const unsigned tg = og / nx;
            if (og + 1u == (tg + 1u) * nx) xb_add(&bar[XB_TOPGEN], 1u);
            else XB_SPIN(xb_ld(&bar[XB_TOPGEN]) == tg, bar);
            __builtin_amdgcn_fence(__ATOMIC_ACQUIRE, "agent");
            xb_add(&bar[XB_XGEN(b.x)], 1u);
            asm volatile("s_waitcnt vmcnt(0)" ::: "memory");
        } else {
            XB_SPIN(xb_ld(&bar[XB_XGEN(b.x)]) == gen, bar);
            __builtin_amdgcn_fence(__ATOMIC_ACQUIRE, "agent");
            asm volatile("s_waitcnt vmcnt(0)" ::: "memory");
        }
    }
    __syncthreads();
}

constexpr int S_ = 8192, DM = 2048, FF = 5632, FF2 = 11264, NMIX = 17664, NMIXSRC = 17440, NADA = 18432;
constexpr int AH = 8, AW = 1024, NBLK = 32;
constexpr int SH = 32, SGRP = 4, XBCW = 3072, NCH = 32;
constexpr int CWID = 1024;
constexpr int MC_Q = 0, MC_K = 1024, MC_V = 2048, MC_Z = 3072, MC_XBC = 5120, MC_DT = 8192, MC_CB = 8448, MC_CC = 9472, MC_CX = 10496, MC_GA = 11520, MC_GS = 13568, MC_GC = 15616;
constexpr float LOG2E = 1.4426950408889634f;
constexpr float QSCALE = 0.08838834764831845f * 1.4426950408889634f;
constexpr float EPS = 1e-6f;

constexpr size_t KiB = 1024, MiB = 1u << 20;
constexpr size_t WS_CTL = 0;
constexpr size_t WS_CNT = 32 * KiB;
constexpr size_t ZERO_BYTES = 64 * KiB;
static_assert(WS_CNT + 2 * 8 * 32 * 4 <= ZERO_BYTES && (4096 + 3456) * 4 <= WS_CNT, "zero region");
constexpr size_t WS_ADA = 64 * KiB;
constexpr size_t WS_BIASIN = WS_ADA + 2 * NADA * 4;
constexpr size_t WS_BIASMIX = WS_BIASIN + 4 * FF2 * 4;
static_assert(WS_BIASMIX + 2 * NMIX * 4 <= 2 * MiB, "small vectors");
constexpr size_t WS_KMEAN = 2 * MiB;
constexpr size_t WS_LUT = WS_KMEAN + 8 * 32 * 128 * 4;
constexpr size_t WS_ACST = 3 * MiB;
constexpr size_t WS_ML = 4 * MiB;
constexpr size_t WS_LIST = 6 * MiB;
constexpr size_t WS_RSP = 14 * MiB;
constexpr size_t WS_GSP = 15 * MiB;
constexpr size_t WS_W = 16 * MiB;
constexpr size_t W_IN = 0, W_IN_SZ = (size_t)FF2 * DM * 2;
constexpr size_t W_OUT = W_IN + 2 * W_IN_SZ, W_OUT_SZ = (size_t)DM * FF * 2;
constexpr size_t W_MIX = W_OUT + 2 * W_OUT_SZ, W_MIX_SZ = (size_t)NMIX * DM * 2;
constexpr size_t W_BA = W_MIX + W_MIX_SZ, W_BS = W_BA + (size_t)DM * 1024 * 2, W_BC = W_BS + (size_t)DM * 2048 * 2, W_MO = W_BC + (size_t)DM * 1024 * 2;
constexpr size_t LAYER_W = W_MO + (size_t)DM * DM * 2;
constexpr size_t WS_XB = WS_W + 2 * LAYER_W;
constexpr size_t WS_ACT = WS_XB + (size_t)S_ * DM * 2;
constexpr size_t A_HID = WS_ACT;
constexpr size_t A_MIX = WS_ACT;
constexpr size_t A_QN = A_MIX + (size_t)S_ * NMIX * 2;
constexpr size_t A_KN = A_QN + (size_t)S_ * AW * 2;
constexpr size_t A_XC = A_KN + (size_t)S_ * AW * 2;
constexpr size_t A_XDT = A_XC + (size_t)S_ * XBCW * 2;
constexpr size_t A_BT = A_XDT + (size_t)2048 * S_ * 2;
constexpr size_t A_STATES = A_BT + (size_t)512 * S_ * 2;
constexpr size_t A_PREV = A_STATES + (size_t)NCH * SH * 64 * 128 * 4;
constexpr size_t A_CBM = A_PREV + (size_t)NCH * SH * 64 * 128 * 2;
constexpr size_t A_YS = A_CBM + (size_t)NCH * SGRP * 256 * 256 * 2;
constexpr size_t A_YCONV = A_YS + (size_t)S_ * DM * 2;
constexpr size_t A_PART = A_YCONV + (size_t)S_ * CWID * 2;
constexpr size_t A_YATTN = A_PART + (size_t)4 * S_ * AW * 2;
constexpr size_t WS_END = A_YATTN + (size_t)S_ * AW * 2;
constexpr size_t A_P0 = A_STATES;
constexpr size_t A_P1 = A_PART;
constexpr size_t A_MRG = A_XDT;
static_assert(A_P0 + (size_t)S_ * DM * 4 <= A_YS && A_P1 + (size_t)S_ * DM * 4 <= A_YATTN && A_MRG + (size_t)S_ * DM * 2 <= A_BT, "overlays");
static_assert(WS_END <= (size_t)1100 * MiB, "workspace map must stay under the guaranteed scratch size");
static_assert(A_HID + (size_t)S_ * FF * 2 <= A_QN, "HID overlays MIX only");
constexpr int CW_BAR = 4096;

constexpr int RING_BYTES = 131072;
constexpr int SCR_OFF = RING_BYTES, SCR_BYTES = 12288;
constexpr int MISC_OFF = SCR_OFF + SCR_BYTES;
constexpr int LDS_BYTES = 147456;
static_assert(MISC_OFF + 256 <= LDS_BYTES, "LDS map");
constexpr int NWAVES = 8;


typedef float f32x16 __attribute__((ext_vector_type(16)));
typedef float f32x2 __attribute__((ext_vector_type(2)));
typedef short s16x4 __attribute__((ext_vector_type(4)));
struct Ctx {
    unsigned char* lds;
    int tid, lane, wave, G, bid;
    const float* in[21];
    float* out; unsigned char* ws;
};
enum { IN_X = 0, IN_C, IN_WADA, IN_BADA, IN_GAIN, IN_WFFIN, IN_WFFOUT, IN_WMIX, IN_QKN, IN_RELB, IN_WSCONV, IN_BSCONV, IN_DTB, IN_ALOG, IN_SSDD, IN_SSDN, IN_WSC, IN_WBA, IN_WBS, IN_WBC, IN_WMO };

__device__ __forceinline__ float wave_sum(float v) {
#pragma unroll
    for (int o = 1; o < 64; o <<= 1) v += __shfl_xor(v, o);
    return v;
}
__device__ __forceinline__ float bf2f(bf16 b) { return __uint_as_float((unsigned)b << 16); }
__device__ __forceinline__ unsigned cvtpk(float lo, float hi) { unsigned r; asm volatile("v_cvt_pk_bf16_f32 %0, %1, %2" : "=v"(r) : "v"(lo), "v"(hi)); return r; }
#define UNPACK8(V_, f) do { const v4u u8_ = (V_); f[0] = __uint_as_float(u8_.x << 16); f[1] = __uint_as_float(u8_.x & 0xffff0000u); f[2] = __uint_as_float(u8_.y << 16); f[3] = __uint_as_float(u8_.y & 0xffff0000u); \
                           f[4] = __uint_as_float(u8_.z << 16); f[5] = __uint_as_float(u8_.z & 0xffff0000u); f[6] = __uint_as_float(u8_.w << 16); f[7] = __uint_as_float(u8_.w & 0xffff0000u); } while (0)
#define PACK8(f) ((v4u){cvtpk(f[0], f[1]), cvtpk(f[2], f[3]), cvtpk(f[4], f[5]), cvtpk(f[6], f[7])})
__device__ __forceinline__ int crow(int r, int hi) { return (r & 3) + 8 * (r >> 2) + 4 * hi; }
__device__ __forceinline__ float silu_f(float v) { return v / (1.0f + __expf(-v)); }

__device__ __forceinline__ void ph_ada(const Ctx& C) {
    const float* cvec = C.in[IN_C]; const float* W = C.in[IN_WADA]; const float* b = C.in[IN_BADA];
    float* ada = (float*)(C.ws + WS_ADA); f32x4* red = (f32x4*)C.lds;
    for (int it = C.bid; it < 256; it += C.G) {
        const int l = it >> 7, j = (it & 127) * 144 + C.lane * 4, k0 = C.wave * 256;
        f32x4 acc = (f32x4){0.f, 0.f, 0.f, 0.f};
        if (C.lane < 36) { const float* Wp = W + ((size_t)l * 2048 + k0) * NADA + j;
#pragma unroll 8
            for (int kk = 0; kk < 256; ++kk) { const float cv = cvec[k0 + kk]; const float s = silu_f(cv); const f32x4 w = *(const f32x4*)(Wp + (size_t)kk * NADA); acc = acc + w * s; }
            red[C.wave * 36 + C.lane] = acc; }
        __syncthreads();
        if (C.tid < 36) { f32x4 t = *(const f32x4*)(b + l * NADA + j);
#pragma unroll
            for (int w = 0; w < 8; ++w) t = t + red[w * 36 + C.tid];
            *(f32x4*)(ada + l * NADA + j) = t; }
        __syncthreads();
    }
}

__device__ __forceinline__ void tr_item(const float* W, int K, int N, int kb0, int nkb, int n0, bf16* WT, int drow0, const float* g1, const float* g2, const float* sh, float* bias, LAS float* scr, int lane) {
    float bacc = 0.f;
    for (int kb = kb0; kb < kb0 + nkb; ++kb) { const int k0 = 64 * kb;
#pragma unroll 8
        for (int i = 0; i < 32; ++i) { const int kk = 2 * i + (lane >> 5); const int k = k0 + kk;
            const float v = W[(size_t)k * N + n0 + (lane & 31)];
            float g = 1.f; if (g1) { g = g1[k]; if (g2) g *= 1.f + g2[k]; }
            if (sh) bacc += sh[k] * v;
            scr[kk * 33 + (lane & 31)] = v * g; }
        LDS_WAIT(); asm volatile("" ::: "memory");
        const int c = lane & 7;
#pragma unroll
        for (int j = 0; j < 4; ++j) { const int n = (lane >> 3) + 8 * j; const LAS float* s = scr + (8 * c) * 33 + n;
            v4u o; o.x = pk2(s[0 * 33], s[1 * 33]); o.y = pk2(s[2 * 33], s[3 * 33]); o.z = pk2(s[4 * 33], s[5 * 33]); o.w = pk2(s[6 * 33], s[7 * 33]);
            *(GAS v4u*)(WT + (size_t)(drow0 + n) * K + k0 + 8 * c) = o; }
        LDS_WAIT(); asm volatile("" ::: "memory"); }
    if (sh) { bacc += __shfl_xor(bacc, 32); if (lane < 32) bias[drow0 + lane] = bacc; }
}
__device__ __forceinline__ void ph_convert(const Ctx& C) {
    LAS float* scr = (LAS float*)((LAS unsigned char*)C.lds + C.wave * 16384);
    const int gw = C.bid * NWAVES + C.wave, NGW = C.G * NWAVES;
    const float* ada = (const float*)(C.ws + WS_ADA);
    constexpr int I_IN = FF2 / 32, I_MIX = NMIXSRC / 32, I_OUT = 4 * (DM / 32), I_B1 = DM / 32, I_B2 = DM / 32;
    constexpr int I_LAYER = 2 * I_IN + I_MIX + 2 * I_OUT + 2 * I_B1 + 2 * I_B2;
    for (int it = gw; it < 2 * I_LAYER; it += NGW) {
        const int l = it / I_LAYER; int r = it - l * I_LAYER;
        unsigned char* wl = C.ws + WS_W + (size_t)l * LAYER_W;
        const float* adal = ada + l * NADA; const float* gain = C.in[IN_GAIN] + l * 3 * 2048;
        if (r < 2 * I_IN) { const int f = r / I_IN; r -= f * I_IN; const int sub = f * 2;
            const int n0 = 32 * r;
            const int bj = n0 / FF, j = n0 - bj * FF, drow0 = (j / 128) * 256 + bj * 128 + (j % 128);
            tr_item(C.in[IN_WFFIN] + (size_t)(l * 2 + f) * DM * FF2, DM, FF2, 0, 32, n0, (bf16*)(wl + W_IN + f * W_IN_SZ), drow0,
                    gain + sub * 2048, adal + (sub * 3 + 1) * 2048, adal + (sub * 3 + 0) * 2048, (float*)(C.ws + WS_BIASIN) + (l * 2 + f) * FF2, scr, C.lane);
            continue; }
        r -= 2 * I_IN;
        if (r < I_MIX) { const int n0 = 32 * r; const int drow0 = n0 < 8224 ? n0 : n0 + 224;
            tr_item(C.in[IN_WMIX] + (size_t)l * DM * NMIXSRC, DM, NMIXSRC, 0, 32, n0, (bf16*)(wl + W_MIX), drow0,
                    gain + 1 * 2048, adal + (1 * 3 + 1) * 2048, adal + (1 * 3 + 0) * 2048, (float*)(C.ws + WS_BIASMIX) + l * NMIX, scr, C.lane);
            continue; }
        r -= I_MIX;
        if (r < 2 * I_OUT) { const int f = r / I_OUT; r -= f * I_OUT; const int kq = r / (DM / 32), n0 = 32 * (r % (DM / 32));
            tr_item(C.in[IN_WFFOUT] + (size_t)(l * 2 + f) * FF * DM, FF, DM, 22 * kq, 22, n0, (bf16*)(wl + W_OUT + f * W_OUT_SZ), n0, nullptr, nullptr, nullptr, nullptr, scr, C.lane);
            continue; }
        r -= 2 * I_OUT;
        if (r < I_B1) { const int n0 = 32 * r;
            tr_item(C.in[IN_WBA] + (size_t)l * 1024 * DM, 1024, DM, 0, 16, n0, (bf16*)(wl + W_BA), n0, nullptr, nullptr, nullptr, nullptr, scr, C.lane); continue; }
        r -= I_B1;
        if (r < I_B2) { const int n0 = 32 * r;
            tr_item(C.in[IN_WBS] + (size_t)l * 2048 * DM, 2048, DM, 0, 32, n0, (bf16*)(wl + W_BS), n0, C.in[IN_SSDN] + l * 2048, nullptr, nullptr, nullptr, scr, C.lane); continue; }
        r -= I_B2;
        if (r < I_B1) { const int n0 = 32 * r;
            tr_item(C.in[IN_WBC] + (size_t)l * 1024 * DM, 1024, DM, 0, 16, n0, (bf16*)(wl + W_BC), n0, nullptr, nullptr, nullptr, nullptr, scr, C.lane); continue; }
        r -= I_B1;
        { const int n0 = 32 * r;
            tr_item(C.in[IN_WMO] + (size_t)l * DM * DM, DM, DM, 0, 32, n0, (bf16*)(wl + W_MO), n0, nullptr, nullptr, nullptr, nullptr, scr, C.lane); }
    }
    for (int it = gw; it < 2 * 224; it += NGW) { const int l = it / 224, row = 8224 + it % 224; GAS v4u* p = (GAS v4u*)(C.ws + WS_W + (size_t)l * LAYER_W + W_MIX + (size_t)row * DM * 2);
#pragma unroll
        for (int j = 0; j < 4; ++j) p[C.lane + 64 * j] = (v4u){0u, 0u, 0u, 0u};
        if (C.lane == 0) ((float*)(C.ws + WS_BIASMIX))[l * NMIX + row] = 0.f; }
    { const float* x = C.in[IN_X]; bf16* XB = (bf16*)(C.ws + WS_XB); float* rsp = (float*)(C.ws + WS_RSP);
      for (int m = gw; m < S_; m += NGW) { const GAS f32x4* xr = (const GAS f32x4*)(x + (size_t)m * DM) + C.lane; float ss = 0.f;
          GAS unsigned long long* o8 = (GAS unsigned long long*)(XB + (size_t)m * DM) + C.lane;
#pragma unroll
          for (int j = 0; j < 8; ++j) { const f32x4 v = xr[64 * j]; ss += (v.x * v.x + v.y * v.y) + (v.z * v.z + v.w * v.w);
              o8[64 * j] = (unsigned long long)pk2(v.x, v.y) | ((unsigned long long)pk2(v.z, v.w) << 32); }
          ss = wave_sum(ss); if (C.lane < 32) rsp[(size_t)m * 32 + C.lane] = C.lane == 0 ? ss : 0.f; } }
    if (C.bid == 0) { float* lut = (float*)(C.ws + WS_LUT); const float* rb = C.in[IN_RELB];
        for (int i = C.tid; i < 8 * 129; i += NWAVES * 64) { const int h = i / 129, d = i % 129; int bk;
            if (d < 16) bk = d; else { const float ratio = logf((float)d / 16.0f) / 2.0794415416798357f; bk = 16 + (int)(ratio * 16.0f); if (bk > 31) bk = 31; }
            lut[h * 132 + d] = rb[bk * 8 + h] * LOG2E; } }
}

__device__ __forceinline__ void prep_qk_unit(const Ctx& C, int l, int u) {
    const int c = u >> 4, h = (u >> 1) & 7, which = u & 1;
    const bf16* MIX = (const bf16*)(C.ws + A_MIX); bf16* dst = (bf16*)(C.ws + (which ? A_KN : A_QN));
    const float* gn = C.in[IN_QKN] + (l * 2 + which) * 128;
    const int l16 = C.tid & 15, rsub = C.tid >> 4;
    float g[8];
#pragma unroll
    for (int e = 0; e < 8; ++e) g[e] = gn[l16 * 8 + e] * (which ? 1.0f : QSCALE);
    float cs[8];
#pragma unroll
    for (int e = 0; e < 8; ++e) cs[e] = 0.f;
#pragma unroll 2
    for (int ps = 0; ps < 8; ++ps) { const int r = 256 * c + ps * 32 + rsub;
        const v4u w = *(const v4u*)(MIX + (size_t)r * NMIX + which * 1024 + h * 128 + l16 * 8);
        float f[8]; UNPACK8(w, f); float ss = 0.f;
#pragma unroll
        for (int e = 0; e < 8; ++e) ss += f[e] * f[e];
        ss += __shfl_xor(ss, 1); ss += __shfl_xor(ss, 2); ss += __shfl_xor(ss, 4); ss += __shfl_xor(ss, 8);
        const float rs = rsqrtf(ss * (1.0f / 128.0f) + EPS);
#pragma unroll
        for (int e = 0; e < 8; ++e) { f[e] = f[e] * rs * g[e]; cs[e] += f[e]; }
        *(v4u*)(dst + (size_t)r * AW + h * 128 + l16 * 8) = PACK8(f); }
    if (which) {
        float* scr = (float*)(C.lds);
#pragma unroll
        for (int e = 0; e < 8; ++e) { cs[e] += __shfl_xor(cs[e], 16); cs[e] += __shfl_xor(cs[e], 32); }
        if (C.lane < 16) {
#pragma unroll
            for (int e = 0; e < 8; ++e) scr[C.wave * 128 + l16 * 8 + e] = cs[e]; }
        __syncthreads();
        if (C.tid < 128) { float s = 0.f;
#pragma unroll
            for (int w = 0; w < 8; ++w) s += scr[w * 128 + C.tid];
            ((float*)(C.ws + WS_KMEAN))[(h * 32 + c) * 128 + C.tid] = s * (1.0f / 256.0f); }
        __syncthreads();
    }
}
__device__ __forceinline__ void prep_ssd_unit(const Ctx& C, int l, int u) {
    const int c = u / 48, s = u % 48, ch0 = 64 * s;
    const bf16* MIX = (const bf16*)(C.ws + A_MIX); bf16* XC = (bf16*)(C.ws + A_XC);
    float* dtL = (float*)(C.lds); float* adL = dtL + 256;
    bf16* T = (bf16*)(C.lds + 4096);
    const int cg = C.tid & 7, rg = C.tid >> 3;
    if (s < 32) {
        if (C.tid < 256) { const float a = -__expf(C.in[IN_ALOG][l * 32 + s]);
            const float raw = bf2f(MIX[(size_t)(256 * c + C.tid) * NMIX + MC_DT + s]) + C.in[IN_DTB][l * 32 + s];
            const float dt = raw > 20.f ? raw : log1pf(__expf(raw));
            dtL[C.tid] = dt; adL[C.tid] = dt * a; }
        __syncthreads();
        if (C.wave == 0) {
            float v0 = adL[4 * C.lane], v1 = adL[4 * C.lane + 1], v2 = adL[4 * C.lane + 2], v3 = adL[4 * C.lane + 3];
            v1 += v0; v2 += v1; v3 += v2; float tot = v3;
#pragma unroll
            for (int o = 1; o < 64; o <<= 1) { const float t = __shfl_up(tot, o); if (C.lane >= o) tot += t; }
            const float base = tot - v3;
            float* ac = (float*)(C.ws + WS_ACST) + (size_t)s * S_ + 256 * c + 4 * C.lane;
            *(f32x4*)ac = (f32x4){base + v0, base + v1, base + v2, base + v3}; }
    }
    const float* wc = C.in[IN_WSCONV] + (size_t)l * 4 * XBCW + ch0 + cg * 8; const float* bc = C.in[IN_BSCONV] + (size_t)l * XBCW + ch0 + cg * 8;
    float raw[7][8];
#pragma unroll
    for (int i = 0; i < 7; ++i) { const int t = 256 * c + 4 * rg - 3 + i;
        if (t >= 0) { const v4u w = *(const v4u*)(MIX + (size_t)t * NMIX + MC_XBC + ch0 + cg * 8); UNPACK8(w, raw[i]); }
        else {
#pragma unroll
            for (int e = 0; e < 8; ++e) raw[i][e] = 0.f; } }
    float wv[4][8], bv[8];
#pragma unroll
    for (int j = 0; j < 4; ++j) { const f32x4 a = *(const f32x4*)(wc + j * XBCW), b = *(const f32x4*)(wc + j * XBCW + 4);
        wv[j][0] = a[0]; wv[j][1] = a[1]; wv[j][2] = a[2]; wv[j][3] = a[3]; wv[j][4] = b[0]; wv[j][5] = b[1]; wv[j][6] = b[2]; wv[j][7] = b[3]; }
    { const f32x4 a = *(const f32x4*)bc, b = *(const f32x4*)(bc + 4); bv[0] = a[0]; bv[1] = a[1]; bv[2] = a[2]; bv[3] = a[3]; bv[4] = b[0]; bv[5] = b[1]; bv[6] = b[2]; bv[7] = b[3]; }
#pragma unroll
    for (int i = 0; i < 4; ++i) { float o[8]; const int rl = 4 * rg + i;
#pragma unroll
        for (int e = 0; e < 8; ++e) { float v = bv[e];
#pragma unroll
            for (int j = 0; j < 4; ++j) v += wv[j][e] * raw[i + j][e];
            o[e] = silu_f(v); }
        *(v4u*)(XC + (size_t)(256 * c + rl) * XBCW + ch0 + cg * 8) = PACK8(o);
        if (s < 40) { const float sc = s < 32 ? dtL[rl] : 1.0f;
#pragma unroll
            for (int e = 0; e < 8; ++e) T[(cg * 8 + e) * 264 + rl] = (bf16)f2bf(o[e] * sc); } }
    if (s < 40) {
        __syncthreads();
        bf16* dstT = s < 32 ? (bf16*)(C.ws + A_XDT) + (size_t)(64 * s) * S_ : (bf16*)(C.ws + A_BT) + (size_t)(64 * (s - 32)) * S_;
        const int ch = C.tid >> 3;
#pragma unroll
        for (int jj = 0; jj < 4; ++jj) { const int chunk = (C.tid & 7) + 8 * jj;
            const v4u w = *(const v4u*)(T + ch * 264 + chunk * 8);
            *(v4u*)(dstT + (size_t)ch * S_ + 256 * c + chunk * 8) = w; }
    }
    __syncthreads();
}
__device__ __forceinline__ void prep_conv_unit(const Ctx& C, int l, int u) {
    const int c = u >> 4, s = u & 15, ch0 = 64 * s, cg = C.tid & 7, rg = C.tid >> 3;
    const bf16* MIX = (const bf16*)(C.ws + A_MIX); bf16* Y = (bf16*)(C.ws + A_YCONV);
    const float* wc = C.in[IN_WSC] + (size_t)l * 3 * CWID + ch0 + cg * 8;
    float pr[6][8];
#pragma unroll
    for (int i = 0; i < 6; ++i) { const int t = 256 * c + 4 * rg - 2 + i;
        if (t >= 0) { const v4u a = *(const v4u*)(MIX + (size_t)t * NMIX + MC_CC + ch0 + cg * 8), b = *(const v4u*)(MIX + (size_t)t * NMIX + MC_CX + ch0 + cg * 8);
            float fa[8], fb[8]; UNPACK8(a, fa); UNPACK8(b, fb);
#pragma unroll
            for (int e = 0; e < 8; ++e) pr[i][e] = fa[e] * fb[e]; }
        else {
#pragma unroll
            for (int e = 0; e < 8; ++e) pr[i][e] = 0.f; } }
    float wv[3][8];
#pragma unroll
    for (int j = 0; j < 3; ++j) { const f32x4 a = *(const f32x4*)(wc + j * CWID), b = *(const f32x4*)(wc + j * CWID + 4);
        wv[j][0] = a[0]; wv[j][1] = a[1]; wv[j][2] = a[2]; wv[j][3] = a[3]; wv[j][4] = b[0]; wv[j][5] = b[1]; wv[j][6] = b[2]; wv[j][7] = b[3]; }
#pragma unroll
    for (int i = 0; i < 4; ++i) { const int t = 256 * c + 4 * rg + i;
        const v4u g = *(const v4u*)(MIX + (size_t)t * NMIX + MC_CB + ch0 + cg * 8); float fg[8], o[8]; UNPACK8(g, fg);
#pragma unroll
        for (int e = 0; e < 8; ++e) o[e] = fg[e] * (wv[0][e] * pr[i][e] + wv[1][e] * pr[i + 1][e] + wv[2][e] * pr[i + 2][e]);
        *(v4u*)(Y + (size_t)t * CWID + ch0 + cg * 8) = PACK8(o); }
}
__device__ __forceinline__ void ph_prep(const Ctx& C, int l) {
    for (int u = C.bid; u < 512 + 1536 + 512; u += C.G) {
        if (u < 512) prep_qk_unit(C, l, u);
        else if (u < 2048) prep_ssd_unit(C, l, u - 512);
        else prep_conv_unit(C, l, u - 2048);
    }
}

__device__ __forceinline__ void select_unit(const Ctx& C, int l, int u) {
    const int h = u >> 7, q0 = 64 * (u & 127), qb = q0 >> 8;
    if (qb == 0) return;
    float* km = (float*)C.lds; float* sc = km + 32 * 128;
    const float* KM = (const float*)(C.ws + WS_KMEAN) + h * 32 * 128;
    for (int i = C.tid; i < 32 * 128 / 4; i += NWAVES * 64) ((f32x4*)km)[i] = ((const f32x4*)KM)[i];
    __syncthreads();
    const int q = q0 + C.lane;
    if (4 * C.wave < qb) {
        const bf16* qp = (const bf16*)(C.ws + A_QN) + (size_t)q * AW + h * 128;
        float s4[4] = {0.f, 0.f, 0.f, 0.f};
#pragma unroll 4
        for (int dc = 0; dc < 16; ++dc) { const v4u w = *(const v4u*)(qp + dc * 8); float f[8]; UNPACK8(w, f);
#pragma unroll
            for (int jj = 0; jj < 4; ++jj) { const f32x4 a = *(const f32x4*)(km + (4 * C.wave + jj) * 128 + dc * 8), b = *(const f32x4*)(km + (4 * C.wave + jj) * 128 + dc * 8 + 4);
                s4[jj] += (f[0] * a[0] + f[1] * a[1]) + (f[2] * a[2] + f[3] * a[3]) + (f[4] * b[0] + f[5] * b[1]) + (f[6] * b[2] + f[7] * b[3]); } }
#pragma unroll
        for (int jj = 0; jj < 4; ++jj) sc[C.lane * 33 + 4 * C.wave + jj] = s4[jj];
    }
    __syncthreads();
    if (C.tid < 64) { const int qq = q0 + C.tid; const float* sr = sc + C.tid * 33;
        int j0 = -1, j1 = -1, j2 = -1; float b0 = -INFINITY, b1 = -INFINITY, b2 = -INFINITY;
        for (int j = 0; j < qb; ++j) { const float v = sr[j];
            if (v > b0) { b2 = b1; j2 = j1; b1 = b0; j1 = j0; b0 = v; j0 = j; }
            else if (v > b1) { b2 = b1; j2 = j1; b1 = v; j1 = j; }
            else if (v > b2) { b2 = v; j2 = j; } }
        unsigned* cnt = (unsigned*)(C.ws + WS_CNT) + (l * 8 + h) * 32; unsigned* list = (unsigned*)(C.ws + WS_LIST) + (size_t)h * 32 * S_;
        if (j0 >= 0) { const unsigned p = atomicAdd(cnt + j0, 1u); list[(size_t)j0 * S_ + p] = (unsigned)qq | (1u << 16); }
        if (j1 >= 0) { const unsigned p = atomicAdd(cnt + j1, 1u); list[(size_t)j1 * S_ + p] = (unsigned)qq | (2u << 16); }
        if (j2 >= 0) { const unsigned p = atomicAdd(cnt + j2, 1u); list[(size_t)j2 * S_ + p] = (unsigned)qq | (3u << 16); }
    }
    __syncthreads();
}
#define MFMA32(a, b, c) __builtin_amdgcn_mfma_f32_32x32x16_bf16(__builtin_bit_cast(bf16x8, a), __builtin_bit_cast(bf16x8, b), c, 0, 0, 0)
__device__ __forceinline__ void ssd_state_unit(const Ctx& C, int u) {
    const int c = u >> 5, hh = u & 31, g = hh >> 3, mi = C.wave >> 2, ni = C.wave & 3, r32 = C.lane & 31, hi = C.lane >> 5;
    const bf16* Ap = (const bf16*)(C.ws + A_XDT) + (size_t)(64 * hh + 32 * mi + r32) * S_ + 256 * c + 8 * hi;
    const bf16* Bp = (const bf16*)(C.ws + A_BT) + (size_t)(128 * g + 32 * ni + r32) * S_ + 256 * c + 8 * hi;
    const float* ac = (const float*)(C.ws + WS_ACST) + (size_t)hh * S_ + 256 * c; const float aend = ac[255];
    f32x16 acc = {};
#pragma unroll 4
    for (int ks = 0; ks < 16; ++ks) { const v4u a = *(const v4u*)(Ap + 16 * ks), b = *(const v4u*)(Bp + 16 * ks);
        const f32x4 d0 = *(const f32x4*)(ac + 16 * ks + 8 * hi), d1 = *(const f32x4*)(ac + 16 * ks + 8 * hi + 4);
        float f[8]; UNPACK8(a, f);
        f[0] *= __expf(aend - d0[0]); f[1] *= __expf(aend - d0[1]); f[2] *= __expf(aend - d0[2]); f[3] *= __expf(aend - d0[3]);
        f[4] *= __expf(aend - d1[0]); f[5] *= __expf(aend - d1[1]); f[6] *= __expf(aend - d1[2]); f[7] *= __expf(aend - d1[3]);
        const v4u a2 = PACK8(f);
        acc = MFMA32(a2, b, acc); }
    float* st = (float*)(C.ws + A_STATES) + ((size_t)(c * 32 + hh) * 64 + 32 * mi) * 128 + 32 * ni + r32;
#pragma unroll
    for (int r = 0; r < 16; ++r) st[(size_t)crow(r, hi) * 128] = acc[r];
}
__device__ __forceinline__ void ssd_cb_unit(const Ctx& C, int u) {
    const int c = u >> 2, g = u & 3, r32 = C.lane & 31, hi = C.lane >> 5;
    const bf16* XC = (const bf16*)(C.ws + A_XC); bf16* CB = (bf16*)(C.ws + A_CBM) + (size_t)(c * 4 + g) * 65536;
    for (int tt = C.wave; tt < 36; tt += NWAVES) { int li = 0; while ((li + 1) * (li + 2) / 2 <= tt) ++li; const int si = tt - li * (li + 1) / 2;
        const bf16* Ap = XC + (size_t)(256 * c + 32 * li + r32) * XBCW + 2560 + 128 * g + 8 * hi;
        const bf16* Bp = XC + (size_t)(256 * c + 32 * si + r32) * XBCW + 2048 + 128 * g + 8 * hi;
        f32x16 acc = {};
#pragma unroll
        for (int ks = 0; ks < 8; ++ks) { const v4u a = *(const v4u*)(Ap + 16 * ks), b = *(const v4u*)(Bp + 16 * ks); acc = MFMA32(a, b, acc); }
        bf16* o = CB + (size_t)(32 * li) * 256 + 32 * si + r32;
#pragma unroll
        for (int r = 0; r < 16; ++r) o[(size_t)crow(r, hi) * 256] = (bf16)f2bf(acc[r]); }
}
__device__ __forceinline__ void ph_select(const Ctx& C, int l) {
    for (int u = C.bid; u < 1024 + 1024 + 128; u += C.G) {
        if (u < 1024) select_unit(C, l, u);
        else if (u < 2048) ssd_state_unit(C, u - 1024);
        else ssd_cb_unit(C, u - 2048);
    }
}

__device__ __forceinline__ void ssd_recur(const Ctx& C) {
    const float* ST = (const float*)(C.ws + A_STATES); bf16* PV = (bf16*)(C.ws + A_PREV); const float* ACS = (const float*)(C.ws + WS_ACST);
    for (int e2 = C.bid * (NWAVES * 64) + C.tid; e2 < 32 * 64 * 64; e2 += C.G * NWAVES * 64) {
        const int hh = e2 >> 12, rem = e2 & 4095, p = rem >> 6, n = (rem & 63) * 2;
        float p0 = 0.f, p1 = 0.f;
        for (int c = 0; c < NCH; ++c) { const size_t off = ((size_t)(c * 32 + hh) * 64 + p) * 128 + n;
            *(unsigned*)(PV + off) = pk2(p0, p1);
            const float dec = __expf(ACS[(size_t)hh * S_ + 256 * c + 255]); const f32x2 st = *(const f32x2*)(ST + off);
            p0 = dec * p0 + st.x; p1 = dec * p1 + st.y; }
    }
}
constexpr int SHM_T = 64 * 128 * 2;
#define KSWZ(row, colB) ((row) * 256 + ((colB) ^ (((row) & 7) << 4)))
__device__ __forceinline__ int v_st(int k, int c) { const int kk = (k & ~0xC) | ((k & 4) << 1) | ((k & 8) >> 1); return ((kk >> 3) * 4 + (c >> 5)) * 512 + ((kk & 7) * 32 + (c & 31)) * 2; }
__device__ __forceinline__ int v_rd_base(int lane) { return ((lane & 3) << 3) | (((lane >> 2) & 3) << 6) | (((lane >> 4) & 1) << 5) | (((lane >> 5) & 1) << 8); }
constexpr int v_rd_off(int d0, int ks, int half) { return d0 * 512 + ks * 4096 + half * 2048; }
template <int KB>
__device__ __forceinline__ void qkt(f32x16& p0, f32x16& p1, const char* K_lds, int r32, int hi, const bf16x8* qr, float cinit) {
#pragma unroll
    for (int r = 0; r < 16; ++r) { p0[r] = cinit; p1[r] = cinit; }
    const char* kb[4];
#pragma unroll
    for (int dd = 0; dd < 4; ++dd) kb[dd] = K_lds + KB * SHM_T + KSWZ(r32, (dd * 16 + hi * 8) * 2);
#pragma unroll
    for (int d0 = 0; d0 < 8; ++d0) { const char* a = kb[d0 & 3] + (d0 >> 2) * 128;
        const bf16x8 b0 = *reinterpret_cast<const bf16x8*>(a);
        const bf16x8 b1 = *reinterpret_cast<const bf16x8*>(a + 32 * 256);
        p0 = __builtin_amdgcn_mfma_f32_32x32x16_bf16(b0, qr[d0], p0, 0, 0, 0);
        p1 = __builtin_amdgcn_mfma_f32_32x32x16_bf16(b1, qr[d0], p1, 0, 0, 0); }
}
template <int VB>
__device__ __forceinline__ void pv_tile(f32x16* o, int vb0, bf16x8 pa0, bf16x8 pa1, bf16x8 pa2, bf16x8 pa3) {
#define TRRD(dst, off) asm volatile("ds_read_b64_tr_b16 %0, %1 offset:%2" : "=&v"(dst) : "v"(vb0), "i"(off) : "memory")
#define PV_D0(d0) do { s16x4 l0, l1, l2, l3, h0, h1, h2, h3; constexpr int b_ = VB * SHM_T + v_rd_off(d0, 0, 0); \
        TRRD(l0, b_); TRRD(h0, b_ + 2048); TRRD(l1, b_ + 4096); TRRD(h1, b_ + 6144); TRRD(l2, b_ + 8192); TRRD(h2, b_ + 10240); TRRD(l3, b_ + 12288); TRRD(h3, b_ + 14336); \
        asm volatile("s_waitcnt lgkmcnt(0)" ::: "memory"); __builtin_amdgcn_sched_barrier(0); \
        o[d0] = __builtin_amdgcn_mfma_f32_32x32x16_bf16(pa0, (bf16x8){l0[0], l0[1], l0[2], l0[3], h0[0], h0[1], h0[2], h0[3]}, o[d0], 0, 0, 0); \
        o[d0] = __builtin_amdgcn_mfma_f32_32x32x16_bf16(pa1, (bf16x8){l1[0], l1[1], l1[2], l1[3], h1[0], h1[1], h1[2], h1[3]}, o[d0], 0, 0, 0); \
        o[d0] = __builtin_amdgcn_mfma_f32_32x32x16_bf16(pa2, (bf16x8){l2[0], l2[1], l2[2], l2[3], h2[0], h2[1], h2[2], h2[3]}, o[d0], 0, 0, 0); \
        o[d0] = __builtin_amdgcn_mfma_f32_32x32x16_bf16(pa3, (bf16x8){l3[0], l3[1], l3[2], l3[3], h3[0], h3[1], h3[2], h3[3]}, o[d0], 0, 0, 0); } while (0)
    PV_D0(0); PV_D0(1); PV_D0(2); PV_D0(3);
#undef PV_D0
#undef TRRD
}
__device__ __forceinline__ void sm_step(f32x16& p0, f32x16& p1, float& m_reg, float& l_reg, f32x16* o, float* al_l, int r32, int hi, bf16x8& pa0, bf16x8& pa1, bf16x8& pa2, bf16x8& pa3) {
    float pmax = p0[0];
#pragma unroll
    for (int r = 1; r < 16; ++r) pmax = fmaxf(pmax, p0[r]);
#pragma unroll
    for (int r = 0; r < 16; ++r) pmax = fmaxf(pmax, p1[r]);
    { auto rr = __builtin_amdgcn_permlane32_swap(__float_as_uint(pmax), __float_as_uint(pmax), false, false); pmax = fmaxf(__uint_as_float(rr[0]), __uint_as_float(rr[1])); }
    const float mn = fmaxf(m_reg, pmax); const float alpha = __builtin_amdgcn_exp2f(m_reg - mn); m_reg = mn;
    float ps = 0.f;
#pragma unroll
    for (int r = 0; r < 16; ++r) { p0[r] = __builtin_amdgcn_exp2f(p0[r] - mn); ps += p0[r]; }
#pragma unroll
    for (int r = 0; r < 16; ++r) { p1[r] = __builtin_amdgcn_exp2f(p1[r] - mn); ps += p1[r]; }
    { auto rr = __builtin_amdgcn_permlane32_swap(__float_as_uint(ps), __float_as_uint(ps), false, false); ps = __uint_as_float(rr[0]) + __uint_as_float(rr[1]); }
    l_reg = l_reg * alpha + ps;
    if (__any(alpha < 1.f)) { if (hi == 0) al_l[r32] = alpha; asm volatile("s_waitcnt lgkmcnt(0)" ::: "memory");
#pragma unroll
        for (int d_ = 0; d_ < 4; ++d_)
#pragma unroll
            for (int r = 0; r < 16; ++r) o[d_][r] *= al_l[crow(r, hi)]; }
#define PK4(P, B_, OUT) do { unsigned a0 = cvtpk(P[B_ + 0], P[B_ + 1]), a1 = cvtpk(P[B_ + 2], P[B_ + 3]); unsigned b0 = cvtpk(P[B_ + 4], P[B_ + 5]), b1 = cvtpk(P[B_ + 6], P[B_ + 7]); \
        auto r0 = __builtin_amdgcn_permlane32_swap(a0, b0, false, false); auto r1 = __builtin_amdgcn_permlane32_swap(a1, b1, false, false); \
        v4u w = {r0[0], r1[0], r0[1], r1[1]}; OUT = __builtin_bit_cast(bf16x8, w); } while (0)
    PK4(p0, 0, pa0); PK4(p0, 8, pa1); PK4(p1, 0, pa2); PK4(p1, 8, pa3);
#undef PK4
}
__device__ __forceinline__ void attn_item(const Ctx& C, int h, int j, bool own, int k, int cnt) {
    const int tid = C.tid, wid = C.wave, lane = C.lane, r32 = lane & 31, hi = lane >> 5;
    char* V_lds = (char*)C.lds; char* K_lds = (char*)C.lds + 4 * SHM_T;
    float* wsf = (float*)(C.lds + SCR_OFF) + wid * 64; float* li_l = wsf; float* al_l = wsf + 32;
    int* qtab = (int*)(C.lds + SCR_OFF + 2048) + wid * 32; float* lut = (float*)(C.lds + SCR_OFF + 3072);
    const bf16* KN = (const bf16*)(C.ws + A_KN); const bf16* QN = (const bf16*)(C.ws + A_QN); const bf16* MIX = (const bf16*)(C.ws + A_MIX);
    __syncthreads();
    { const int sr = tid >> 4, sc = (tid & 15) * 8; const int kws = KSWZ(sr, sc * 2), vst0 = v_st(sr, sc), vst1 = v_st(32 + sr, sc);
      v4u kr[4][2], vr[4][2];
#pragma unroll
      for (int t = 0; t < 4; ++t) { const size_t row = (size_t)(256 * j + 64 * t + sr);
          kr[t][0] = *(const v4u*)(KN + row * AW + h * 128 + sc); kr[t][1] = *(const v4u*)(KN + (row + 32) * AW + h * 128 + sc); }
#pragma unroll
      for (int t = 0; t < 4; ++t) { const size_t row = (size_t)(256 * j + 64 * t + sr);
          vr[t][0] = *(const v4u*)(MIX + row * NMIX + MC_V + h * 128 + sc); vr[t][1] = *(const v4u*)(MIX + (row + 32) * NMIX + MC_V + h * 128 + sc); }
#pragma unroll
      for (int t = 0; t < 4; ++t) { *(v4u*)(K_lds + t * SHM_T + kws) = kr[t][0]; *(v4u*)(K_lds + t * SHM_T + kws + 32 * 256) = kr[t][1];
          *(v4u*)(V_lds + t * SHM_T + vst0) = vr[t][0]; *(v4u*)(V_lds + t * SHM_T + vst1) = vr[t][1]; }
      if (tid < 129) lut[tid] = ((const float*)(C.ws + WS_LUT))[h * 132 + tid]; }
    __syncthreads();
    int q, slot; bool valid;
    if (own) { q = 256 * j + 32 * wid + r32; slot = 0; valid = true; }
    else { const int e = 256 * k + 32 * wid + r32; valid = e < cnt; const unsigned ent = ((const unsigned*)(C.ws + WS_LIST))[((size_t)h * 32 + j) * S_ + (valid ? e : 0)]; q = (int)(ent & 0xffffu); slot = (int)(ent >> 16); }
    if (!own && 256 * k + 32 * wid >= cnt) return;
    if (hi == 0) qtab[r32] = valid ? (q | (slot << 16)) : -1;
    bf16x8 qr[8];
#pragma unroll
    for (int d0 = 0; d0 < 8; ++d0) qr[d0] = *reinterpret_cast<const bf16x8*>(QN + (size_t)q * AW + h * 128 + d0 * 16 + hi * 8);
    float m_reg = -1e30f, l_reg = 0.f; f32x16 o[4] = {};
    const int vb0 = (int)(uintptr_t)V_lds + v_rd_base(lane);
    const float far = lut[128];
    const bool near = own || __any(valid && (q - (256 * j + 255) < 128));
    f32x16 p0, p1; bf16x8 pa0, pa1, pa2, pa3;
#define ATT_TILE(t) do { if (!own || 64 * (t) <= 32 * wid + 31) { \
        qkt<t>(p0, p1, K_lds, r32, hi, qr, 0.f); \
        if (near) { const int dq = q - (256 * j + 64 * (t)) - 4 * hi; \
            _Pragma("unroll") for (int r = 0; r < 16; ++r) { const int cc = (r & 3) + 8 * (r >> 2); const int d0_ = dq - cc, d1_ = d0_ - 32; \
                p0[r] = d0_ < 0 ? -INFINITY : p0[r] + lut[d0_ < 128 ? d0_ : 128]; p1[r] = d1_ < 0 ? -INFINITY : p1[r] + lut[d1_ < 128 ? d1_ : 128]; } } \
        else { _Pragma("unroll") for (int r = 0; r < 16; ++r) { p0[r] += far; p1[r] += far; } } \
        sm_step(p0, p1, m_reg, l_reg, o, al_l, r32, hi, pa0, pa1, pa2, pa3); \
        pv_tile<t>(o, vb0, pa0, pa1, pa2, pa3); } } while (0)
    ATT_TILE(0); ATT_TILE(1); ATT_TILE(2); ATT_TILE(3);
#undef ATT_TILE
    if (hi == 0) li_l[r32] = l_reg; asm volatile("s_waitcnt lgkmcnt(0)" ::: "memory");
    bf16* PART = (bf16*)(C.ws + A_PART);
#pragma unroll
    for (int r = 0; r < 16; ++r) { const int orow = crow(r, hi); const float rl = __builtin_amdgcn_rcpf(li_l[orow]); const int ent = qtab[orow];
        bf16* dst = PART + ((size_t)((ent >> 16) & 3) * S_ + (size_t)(ent & 0xffff)) * AW + h * 128;
#pragma unroll
        for (int d0 = 0; d0 < 4; ++d0) { const float v = o[d0][r] * rl; const float vn = __shfl_xor(v, 1);
            if (ent >= 0 && (r32 & 1) == 0) *(unsigned*)(dst + d0 * 32 + r32) = cvtpk(v, vn); } }
    if (hi == 0 && valid) { float* ml = (float*)(C.ws + WS_ML) + (((size_t)slot * S_ + q) * 8 + h) * 2; *(f32x2*)ml = (f32x2){m_reg, l_reg}; }
}
__device__ __forceinline__ void ph_attn(const Ctx& C, int l) {
    ssd_recur(C);
    const unsigned* cnt = (const unsigned*)(C.ws + WS_CNT) + l * 8 * 32;
    for (int it = C.bid; it < 256 + 31 * 256; it += C.G) {
        if (it < 256) { attn_item(C, it >> 5, it & 31, true, 0, 256); continue; }
        const int r = it - 256, k = r >> 8, h = (r >> 5) & 7, j = r & 31;
        const int n = __builtin_amdgcn_readfirstlane((int)__hip_atomic_load(cnt + h * 32 + j, __ATOMIC_RELAXED, __HIP_MEMORY_SCOPE_AGENT));
        if (256 * k < n) attn_item(C, h, j, false, k, n);
    }
    __syncthreads();
}

__device__ __forceinline__ void ssd_out_unit(const Ctx& C, int l, int u) {
    const int c = u >> 5, hh = u & 31, g = hh >> 3, w = C.wave, r32 = C.lane & 31, hi = C.lane >> 5;
    const float* ac = (const float*)(C.ws + WS_ACST) + (size_t)hh * S_ + 256 * c;
    const int lrow = 32 * w + r32; const float al = ac[lrow];
    f32x16 acc0 = {}, acc1 = {};
    const bf16* Ap = (const bf16*)(C.ws + A_CBM) + ((size_t)(c * 4 + g) * 256 + lrow) * 256 + 8 * hi;
    const bf16* Bp0 = (const bf16*)(C.ws + A_XDT) + (size_t)(64 * hh + r32) * S_ + 256 * c + 8 * hi; const bf16* Bp1 = Bp0 + (size_t)32 * S_;
    for (int ks = 0; ks < 2 * w + 2; ++ks) { const v4u a = *(const v4u*)(Ap + 16 * ks); float f[8]; UNPACK8(a, f);
        const int s0 = 16 * ks + 8 * hi; const f32x4 d0 = *(const f32x4*)(ac + s0), d1 = *(const f32x4*)(ac + s0 + 4);
        f[0] = (s0 + 0 <= lrow) ? f[0] * __expf(al - d0[0]) : 0.f; f[1] = (s0 + 1 <= lrow) ? f[1] * __expf(al - d0[1]) : 0.f;
        f[2] = (s0 + 2 <= lrow) ? f[2] * __expf(al - d0[2]) : 0.f; f[3] = (s0 + 3 <= lrow) ? f[3] * __expf(al - d0[3]) : 0.f;
        f[4] = (s0 + 4 <= lrow) ? f[4] * __expf(al - d1[0]) : 0.f; f[5] = (s0 + 5 <= lrow) ? f[5] * __expf(al - d1[1]) : 0.f;
        f[6] = (s0 + 6 <= lrow) ? f[6] * __expf(al - d1[2]) : 0.f; f[7] = (s0 + 7 <= lrow) ? f[7] * __expf(al - d1[3]) : 0.f;
        const v4u a2 = PACK8(f); const v4u b0 = *(const v4u*)(Bp0 + 16 * ks), b1 = *(const v4u*)(Bp1 + 16 * ks);
        acc0 = MFMA32(a2, b0, acc0); acc1 = MFMA32(a2, b1, acc1); }
    { const float ea = __expf(al);
      const bf16* Cp = (const bf16*)(C.ws + A_XC) + (size_t)(256 * c + lrow) * XBCW + 2560 + 128 * g + 8 * hi;
      const bf16* Pp0 = (const bf16*)(C.ws + A_PREV) + ((size_t)(c * 32 + hh) * 64 + r32) * 128 + 8 * hi; const bf16* Pp1 = Pp0 + 32 * 128;
#pragma unroll 4
      for (int ks = 0; ks < 8; ++ks) { const v4u a = *(const v4u*)(Cp + 16 * ks); float f[8]; UNPACK8(a, f);
#pragma unroll
          for (int e = 0; e < 8; ++e) f[e] *= ea;
          const v4u a2 = PACK8(f); const v4u b0 = *(const v4u*)(Pp0 + 16 * ks), b1 = *(const v4u*)(Pp1 + 16 * ks);
          acc0 = MFMA32(a2, b0, acc0); acc1 = MFMA32(a2, b1, acc1); } }
    const float Dh = C.in[IN_SSDD][l * 32 + hh];
    const bf16* XC = (const bf16*)(C.ws + A_XC); const bf16* MIX = (const bf16*)(C.ws + A_MIX); bf16* YS = (bf16*)(C.ws + A_YS); float* gsp = (float*)(C.ws + WS_GSP);
#pragma unroll
    for (int r = 0; r < 16; ++r) { const size_t row = (size_t)(256 * c + 32 * w + crow(r, hi)); const int col = 64 * hh + r32;
        const float x0 = bf2f(XC[row * XBCW + col]), x1 = bf2f(XC[row * XBCW + col + 32]);
        const float z0 = bf2f(MIX[row * NMIX + MC_Z + col]), z1 = bf2f(MIX[row * NMIX + MC_Z + col + 32]);
        const float y0 = (acc0[r] + Dh * x0) * silu_f(z0), y1 = (acc1[r] + Dh * x1) * silu_f(z1);
        YS[row * DM + col] = (bf16)f2bf(y0); YS[row * DM + col + 32] = (bf16)f2bf(y1);
        float s2 = y0 * y0 + y1 * y1;
        s2 += __shfl_xor(s2, 1); s2 += __shfl_xor(s2, 2); s2 += __shfl_xor(s2, 4); s2 += __shfl_xor(s2, 8); s2 += __shfl_xor(s2, 16);
        if (r32 == 0) gsp[row * 32 + hh] = s2; }
}
__device__ __forceinline__ void attn_merge(const Ctx& C) {
    const bf16* PART = (const bf16*)(C.ws + A_PART); const float* ML = (const float*)(C.ws + WS_ML); bf16* Y = (bf16*)(C.ws + A_YATTN);
    for (int t = C.bid * (NWAVES * 64) + C.tid; t < S_ * 128; t += C.G * NWAVES * 64) {
        const int q = t >> 7, h = (t >> 4) & 7, dc = t & 15; const int ns = 1 + ((q >> 8) < 3 ? (q >> 8) : 3);
        float m[4], lw[4], M = -1e30f;
#pragma unroll
        for (int s = 0; s < 4; ++s) { if (s < ns) { const f32x2 v = *(const f32x2*)(ML + (((size_t)s * S_ + q) * 8 + h) * 2); m[s] = v.x; lw[s] = v.y; M = fmaxf(M, v.x); } else { m[s] = -1e30f; lw[s] = 0.f; } }
        float o[8], W = 0.f;
#pragma unroll
        for (int e = 0; e < 8; ++e) o[e] = 0.f;
#pragma unroll
        for (int s = 0; s < 4; ++s) if (s < ns) { const float wgt = __builtin_amdgcn_exp2f(m[s] - M) * lw[s]; W += wgt;
            const v4u pw = *(const v4u*)(PART + ((size_t)s * S_ + q) * AW + h * 128 + dc * 8); float f[8]; UNPACK8(pw, f);
#pragma unroll
            for (int e = 0; e < 8; ++e) o[e] += wgt * f[e]; }
        const float rw = 1.0f / W;
#pragma unroll
        for (int e = 0; e < 8; ++e) o[e] *= rw;
        *(v4u*)(Y + (size_t)q * AW + h * 128 + dc * 8) = PACK8(o);
    }
}
__device__ __forceinline__ void ph_ssd_out(const Ctx& C, int l) {
    for (int u = C.bid; u < 1024; u += C.G) ssd_out_unit(C, l, u);
    attn_merge(C);
}
__device__ __forceinline__ void ph_ssd_norm(const Ctx& C, int l) {
    bf16* YS = (bf16*)(C.ws + A_YS); const float* gsp = (const float*)(C.ws + WS_GSP);
    for (int t = C.bid * (NWAVES * 64) + C.tid; t < S_ * 256; t += C.G * NWAVES * 64) {
        const int row = t >> 8, c8 = t & 255, g = c8 >> 6;
        const f32x4 a = *(const f32x4*)(gsp + (size_t)row * 32 + g * 8), b = *(const f32x4*)(gsp + (size_t)row * 32 + g * 8 + 4);
        const float rs = rsqrtf((((a[0] + a[1]) + (a[2] + a[3])) + ((b[0] + b[1]) + (b[2] + b[3]))) * (1.0f / 512.0f) + EPS);
        v4u w = *(const v4u*)(YS + (size_t)row * DM + c8 * 8); float f[8]; UNPACK8(w, f);
#pragma unroll
        for (int e = 0; e < 8; ++e) f[e] *= rs;
        *(v4u*)(YS + (size_t)row * DM + c8 * 8) = PACK8(f);
    }
}

constexpr int NPH_PRO = 2, NPH_LAYER = 12, NPH = NPH_PRO + 2 * NPH_LAYER;
struct Args { const float* in[21]; float* out; unsigned char* ws; int ph_lo, ph_hi; };
static_assert(sizeof(Args) == 21 * 8 + 8 + 8 + 8, "Args has no padding");
typedef __attribute__((address_space(4))) const Args* CArgsP;
__global__ void __launch_bounds__(NWAVES * 64, 2) hybrid_fwd(Args args) {
    extern __shared__ __attribute__((aligned(16))) unsigned char lds[];
    const int tid0 = threadIdx.x;
    LAS unsigned char* ldsl = (LAS unsigned char*)lds;
    volatile LAS unsigned* MISC = (volatile LAS unsigned*)(ldsl + MISC_OFF);
    for (int u = tid0; u < 64; u += NWAVES * 64) ((LAS unsigned*)(ldsl + MISC_OFF))[u] = 0u;
    __syncthreads();
    gu32* ctl = (gu32*)(args.ws + WS_CTL);
#define MKCTX() Ctx C; { CArgsP ap_ = (CArgsP)__builtin_amdgcn_kernarg_segment_ptr(); asm volatile("" : "+s"(ap_)); \
        C.lds = lds; C.tid = threadIdx.x; asm volatile("" : "+v"(C.tid)); C.lane = C.tid & 63; C.wave = __builtin_amdgcn_readfirstlane(C.tid >> 6); C.G = gridDim.x; C.bid = blockIdx.x; \
        _Pragma("unroll") for (int i_ = 0; i_ < 21; ++i_) C.in[i_] = (const float*)(const GAS float*)ap_->in[i_]; C.out = (float*)(GAS float*)ap_->out; C.ws = (unsigned char*)(GAS unsigned char*)ap_->ws; }
    const bool multi = (args.ph_hi - args.ph_lo) > 1;
    XcdBarrier bar; bar.bar = (unsigned*)(ctl + CW_BAR); bar.x = 0; bar.st = nullptr;
    if (multi) bar = xcd_barrier_post((unsigned*)(ctl + CW_BAR), MISC + 8);
    const int lo = args.ph_lo, hi = args.ph_hi;
#ifndef PHMASK
#define PHMASK 0xFFFF
#endif
#define KON(kd) (((PHMASK) >> (kd)) & 1)
#define IN(k) (lo <= (k) && (k) < hi)
#define SEAM(k) do { if (IN(k) && IN((k) + 1)) xcd_barrier(bar); } while (0)
    if (KON(0) && IN(0)) { MKCTX(); ph_ada(C); } SEAM(0);
    if (KON(1) && IN(1)) { MKCTX(); ph_convert(C); } SEAM(1);
    for (int l = 0; l < 2; ++l) {
        const int pb = NPH_PRO + l * NPH_LAYER;
#define LAYER_PTRS() unsigned char* wl = C.ws + WS_W + (size_t)l * LAYER_W; const float* ada = (const float*)(C.ws + WS_ADA) + l * NADA; float* rowss = (float*)(C.ws + WS_RSP); bf16* XB = (bf16*)(C.ws + WS_XB); (void)wl; (void)ada; (void)rowss; (void)XB
        if (KON(2) && IN(pb + 0)) { MKCTX(); LAYER_PTRS(); pg8::Gemm g{XB, (const bf16*)(wl + W_IN), S_, FF2, DM}; pg8::StaticOrder S; S.init(S_, FF2, C.G, C.bid);
            pg8::EpiSwiGLU E{(bf16*)(C.ws + A_HID), (const float*)(C.ws + WS_BIASIN) + (size_t)(l * 2 + 0) * FF2, rowss, FF};
            pg8::gemm_phase<pg8::EpiSwiGLU, pg8::StaticOrder, true, true>(ldsl, g, S, E); }
        SEAM(pb + 0);
        if (KON(3) && IN(pb + 1)) { MKCTX(); LAYER_PTRS(); pg8::Gemm g{(const bf16*)(C.ws + A_HID), (const bf16*)(wl + W_OUT), S_, DM, FF}; pg8::StaticOrder S; S.init(S_, DM, C.G, C.bid);
            pg8::EpiResid E{l == 0 ? C.in[IN_X] : C.out, C.out, XB, ada + (0 * 3 + 2) * 2048, 0.5f, rowss};
            pg8::gemm_phase<pg8::EpiResid, pg8::StaticOrder, true, true>(ldsl, g, S, E); }
        SEAM(pb + 1);
        if (KON(4) && IN(pb + 2)) { MKCTX(); LAYER_PTRS(); pg8::Gemm g{XB, (const bf16*)(wl + W_MIX), S_, NMIX, DM}; pg8::StaticOrder S; S.init(S_, NMIX, C.G, C.bid);
            pg8::EpiMix E{(bf16*)(C.ws + A_MIX), (const float*)(C.ws + WS_BIASMIX) + (size_t)l * NMIX, rowss, NMIX, MC_GA / 256};
            pg8::gemm_phase<pg8::EpiMix, pg8::StaticOrder, true, true>(ldsl, g, S, E); }
        SEAM(pb + 2);
        if (KON(5) && IN(pb + 3)) { MKCTX(); ph_prep(C, l); } SEAM(pb + 3);
        if (KON(6) && IN(pb + 4)) { MKCTX(); ph_select(C, l); } SEAM(pb + 4);
        if (KON(7) && IN(pb + 5)) { MKCTX(); ph_attn(C, l); } SEAM(pb + 5);
        if (KON(8) && IN(pb + 6)) { MKCTX(); ph_ssd_out(C, l); } SEAM(pb + 6);
        if (KON(9) && IN(pb + 7)) { MKCTX(); ph_ssd_norm(C, l); } SEAM(pb + 7);
        if (KON(10) && IN(pb + 8)) {
            { MKCTX(); LAYER_PTRS(); pg8::StaticOrder S; S.init(S_, DM, C.G, C.bid); const bf16* MIX = (const bf16*)(C.ws + A_MIX);
              pg8::Gemm g{(const bf16*)(C.ws + A_YATTN), (const bf16*)(wl + W_BA), S_, DM, 1024}; pg8::EpiBr<0> E{MIX + MC_GA, NMIX, nullptr, (float*)(C.ws + A_P0), nullptr};
              pg8::gemm_phase<pg8::EpiBr<0>, pg8::StaticOrder, true, true>(ldsl, g, S, E); }
            { MKCTX(); LAYER_PTRS(); pg8::StaticOrder S; S.init(S_, DM, C.G, C.bid); const bf16* MIX = (const bf16*)(C.ws + A_MIX);
              pg8::Gemm g{(const bf16*)(C.ws + A_YS), (const bf16*)(wl + W_BS), S_, DM, 2048}; pg8::EpiBr<1> E{MIX + MC_GS, NMIX, (const float*)(C.ws + A_P0), (float*)(C.ws + A_P1), nullptr};
              pg8::gemm_phase<pg8::EpiBr<1>, pg8::StaticOrder, true, true>(ldsl, g, S, E); }
            { MKCTX(); LAYER_PTRS(); pg8::StaticOrder S; S.init(S_, DM, C.G, C.bid); const bf16* MIX = (const bf16*)(C.ws + A_MIX);
              pg8::Gemm g{(const bf16*)(C.ws + A_YCONV), (const bf16*)(wl + W_BC), S_, DM, 1024}; pg8::EpiBr<2> E{MIX + MC_GC, NMIX, (const float*)(C.ws + A_P1), nullptr, (bf16*)(C.ws + A_MRG)};
              pg8::gemm_phase<pg8::EpiBr<2>, pg8::StaticOrder, true, true>(ldsl, g, S, E); }
        }
        SEAM(pb + 8);
        if (KON(11) && IN(pb + 9)) { MKCTX(); LAYER_PTRS(); pg8::Gemm g{(const bf16*)(C.ws + A_MRG), (const bf16*)(wl + W_MO), S_, DM, DM}; pg8::StaticOrder S; S.init(S_, DM, C.G, C.bid);
            pg8::EpiResid E{C.out, C.out, XB, ada + (1 * 3 + 2) * 2048, 1.0f, rowss};
            pg8::gemm_phase<pg8::EpiResid, pg8::StaticOrder, true, true>(ldsl, g, S, E); }
        SEAM(pb + 9);
        if (KON(2) && IN(pb + 10)) { MKCTX(); LAYER_PTRS(); pg8::Gemm g{XB, (const bf16*)(wl + W_IN + W_IN_SZ), S_, FF2, DM}; pg8::StaticOrder S; S.init(S_, FF2, C.G, C.bid);
            pg8::EpiSwiGLU E{(bf16*)(C.ws + A_HID), (const float*)(C.ws + WS_BIASIN) + (size_t)(l * 2 + 1) * FF2, rowss, FF};
            pg8::gemm_phase<pg8::EpiSwiGLU, pg8::StaticOrder, true, true>(ldsl, g, S, E); }
        SEAM(pb + 10);
        if (KON(3) && IN(pb + 11)) { MKCTX(); LAYER_PTRS(); pg8::Gemm g{(const bf16*)(C.ws + A_HID), (const bf16*)(wl + W_OUT + W_OUT_SZ), S_, DM, FF}; pg8::StaticOrder S; S.init(S_, DM, C.G, C.bid);
            pg8::EpiResid E{C.out, C.out, XB, ada + (2 * 3 + 2) * 2048, 0.5f, l == 0 ? rowss : nullptr};
            pg8::gemm_phase<pg8::EpiResid, pg8::StaticOrder, true, true>(ldsl, g, S, E); }
        SEAM(pb + 11);
    }
#undef IN
#undef SEAM
}

#ifndef MK_PER_PHASE
#define MK_PER_PHASE 0
#endif
extern "C" void kernel_launch(void* const* d_in, const int* in_sizes, int n_in, void* d_out, int out_size, void* d_ws, size_t ws_size, hipStream_t stream) {
    static int grid = 0;
    if (grid == 0) {
        if (n_in != 21 || in_sizes[0] != S_ * DM || out_size != S_ * DM || ws_size < WS_END) {
            fprintf(stderr, "kernel_launch: unexpected shapes (n_in %d, in0 %d, out %d, ws %zu, need %zu); nothing launched\n", n_in, n_in > 0 ? in_sizes[0] : -1, out_size, ws_size, (size_t)WS_END); grid = -1; return; }
        int dev = 0, cus = 0, per_cu = 0;
        if (hipGetDevice(&dev) != hipSuccess || hipDeviceGetAttribute(&cus, hipDeviceAttributeMultiprocessorCount, dev) != hipSuccess || cus <= 0) { fprintf(stderr, "kernel_launch: device query failed\n"); grid = -1; return; }
        if (hipFuncSetAttribute((const void*)hybrid_fwd, hipFuncAttributeMaxDynamicSharedMemorySize, LDS_BYTES) != hipSuccess) { fprintf(stderr, "kernel_launch: hipFuncSetAttribute failed\n"); grid = -1; return; }
        if (hipOccupancyMaxActiveBlocksPerMultiprocessor(&per_cu, (const void*)hybrid_fwd, NWAVES * 64, LDS_BYTES) != hipSuccess || per_cu < 1)
            fprintf(stderr, "kernel_launch: note: occupancy query reports %d workgroups per CU\n", per_cu);
        (void)hipGetLastError();
        grid = cus;
    }
    if (grid < 0) return;
    if (hipMemsetAsync((char*)d_ws, 0, ZERO_BYTES, stream) != hipSuccess) { fprintf(stderr, "kernel_launch: memset failed\n"); return; }
    Args a{};
    for (int i = 0; i < 21; ++i) a.in[i] = (const float*)d_in[i];
    a.out = (float*)d_out; a.ws = (unsigned char*)d_ws;
#if MK_PER_PHASE
    for (int p = 0; p < NPH; ++p) { a.ph_lo = p; a.ph_hi = p + 1; hipLaunchKernelGGL(hybrid_fwd, dim3(grid), dim3(NWAVES * 64), LDS_BYTES, stream, a); }
#else
    a.ph_lo = 0; a.ph_hi = NPH;
    hipLaunchKernelGGL(hybrid_fwd, dim3(grid), dim3(NWAVES * 64), LDS_BYTES, stream, a);
#endif
    const hipError_t le = hipPeekAtLastError();
    if (le != hipSuccess) fprintf(stderr, "kernel_launch: launch failed: %s\n", hipGetErrorName(le));
}
```

```cpp
#include <hip/hip_runtime.h>
#include <cstdio>
#include <cstdint>
namespace pg8 {
#define PG8_LAS __attribute__((address_space(3)))
typedef unsigned short bf16_t;
typedef short bf16x8 __attribute__((ext_vector_type(8)));
typedef float f32x4 __attribute__((ext_vector_type(4)));
typedef unsigned u32x4 __attribute__((ext_vector_type(4)));
typedef int i32x4 __attribute__((ext_vector_type(4)));
typedef float f32x32 __attribute__((ext_vector_type(32)));
typedef int i32x8 __attribute__((ext_vector_type(8)));
constexpr int BM = 256, BK = 64, HALF = 128, HTB = HALF * BK * 2  , STAGE_BYTES = 8 * HTB, NXCD = 8, WGM = 8;

__host__ __device__ __forceinline__ int lds_byte(int r, int c) { const int st = (r >> 4) * 2 + (c >> 5), rr = r & 15, cc = c & 31, ob = rr * 64 + cc * 2; return st * 1024 + (ob ^ (((ob >> 9) & 1) << 5)); }
__host__ __device__ __forceinline__ void stage_rc(int b, int& R, int& C) { const int st = b / 1024, sb = b % 1024, swz = sb ^ (((sb >> 9) & 1) << 5); R = (st >> 1) * 16 + swz / 64; C = (st & 1) * 32 + (swz % 64) / 2; }
__host__ __device__ __forceinline__ int perm32(int rho) { const int n = rho >> 4, i = rho & 15; return 8 * (i >> 2) + 4 * n + (i & 3); }

struct Unit { int pm, pn; int par = 0; };
struct Gemm { const bf16_t* A; const bf16_t* Bt; int M, N, K; int sa = 0x7f7f7f7f, sb = 0x7f7f7f7f; int nt_probe = 0; };

struct StaticOrder {
    int nM, nN, nwg, G, c;
    __host__ __device__ void init(int M, int N, int G_, int c_) { nM = M / BM; nN = N / BM; nwg = nM * nN; G = G_; c = c_; }
    __host__ __device__ bool next(int i, Unit& u) const {
        const long L = (long)i * G + c; if (L >= nwg) return false;
        int wgid = (int)L; { const int q = nwg / NXCD, r = nwg % NXCD, xcd = wgid % NXCD, off = wgid / NXCD; wgid = (xcd < r ? xcd * (q + 1) : r * (q + 1) + (xcd - r) * q) + off; }
        const int nig = WGM * nN, gid = wgid / nig, fm = gid * WGM, gsz = (nM - fm) < WGM ? (nM - fm) : WGM;
        u.pm = fm + ((wgid % nig) % gsz); u.pn = (wgid % nig) / gsz; return true;
    }
    __device__ __forceinline__ void a_ready(const Unit&) const {}
    __device__ __forceinline__ void done(const Unit&) const {}
};

__device__ __forceinline__ unsigned cvt_pk_bf16(float lo, float hi) { unsigned r; asm volatile("v_cvt_pk_bf16_f32 %0, %1, %2" : "=v"(r) : "v"(lo), "v"(hi)); return r; }
typedef float f32x2 __attribute__((ext_vector_type(2)));
__device__ __forceinline__ float fast_sigmoid(float v) { return __builtin_amdgcn_rcpf(1.0f + __expf(-v)); }
__device__ __forceinline__ float fast_silu(float v) { return v * fast_sigmoid(v); }
__device__ __forceinline__ f32x4 unpack_lo(unsigned a, unsigned b) { return (f32x4){__uint_as_float(a << 16), __uint_as_float(a & 0xffff0000u), __uint_as_float(b << 16), __uint_as_float(b & 0xffff0000u)}; }
constexpr float NORM_EPS = 1e-6f;
__device__ __forceinline__ unsigned pk4_fp8(float a, float b, float c, float d) {
    a = __builtin_amdgcn_fmed3f(a, -448.f, 448.f); b = __builtin_amdgcn_fmed3f(b, -448.f, 448.f); c = __builtin_amdgcn_fmed3f(c, -448.f, 448.f); d = __builtin_amdgcn_fmed3f(d, -448.f, 448.f);
    int w = 0; w = __builtin_amdgcn_cvt_pk_fp8_f32(a, b, w, false); w = __builtin_amdgcn_cvt_pk_fp8_f32(c, d, w, true); return (unsigned)w;
}
typedef unsigned u32x2 __attribute__((ext_vector_type(2)));
constexpr int PG8_BIAS_QF = 336 * 1024 / 4;
constexpr float XS8 = 4.0f, HS8 = 8.0f, WS8 = 64.0f;
constexpr int E8_X = 0x7d7d7d7d, E8_H = 0x7c7c7c7c, E8_W = 0x79797979;
constexpr int RST_OFF = STAGE_BYTES + 22528;
constexpr int BIAS_OFF = STAGE_BYTES + 20480;
struct RstdLoads { f32x4 a, b, c, d; float e, f; };
__device__ __forceinline__ void rstd_issue(const float* rsp, const float* bias0, const Unit& u, RstdLoads& L) {
    int t = threadIdx.x; asm volatile("" : "+v"(t)); const int row = t >> 1, hf = t & 1;
    const f32x4* p = (const f32x4*)(rsp + (size_t)(u.pm * BM + row) * 32 + hf * 16);
    L.a = p[0]; L.b = p[1]; L.c = p[2]; L.d = p[3];
    const float* bp = bias0 + (2 * hf) * PG8_BIAS_QF + row;
    L.e = bp[0]; L.f = bp[PG8_BIAS_QF];
}
__device__ __forceinline__ void rstd_finish(const Unit& u, PG8_LAS unsigned char* lds, const RstdLoads& L) {
    int t = threadIdx.x; asm volatile("" : "+v"(t)); const int row = t >> 1, hf = t & 1;
    const f32x4 a = L.a, b = L.b, c = L.c, d = L.d;
    float s = (((a[0] + a[1]) + (a[2] + a[3])) + ((b[0] + b[1]) + (b[2] + b[3]))) + (((c[0] + c[1]) + (c[2] + c[3])) + ((d[0] + d[1]) + (d[2] + d[3])));
    const float o = __shfl_xor(s, 1); s = hf ? o + s : s + o;
    if (hf == 0) ((PG8_LAS float*)(lds + RST_OFF))[u.par * 256 + row] = rsqrtf(s * (1.0f / 2048.0f) + NORM_EPS);
    float bs = L.e + L.f; const float bo = __shfl_xor(bs, 1); bs = hf ? bo + bs : bs + bo;
    if (hf == 0) ((PG8_LAS float*)(lds + BIAS_OFF))[u.par * 256 + row] = bs;
}
template <bool F8OUT> struct EpiSwiGLU {
    static constexpr bool PERM = true, AFTER_DRAIN = false, PRE = true, MID = false; static constexpr int SA = E8_W, SB = E8_X;
    bf16_t* O; const float* bias; const float* rsp; int ldo; PG8_LAS unsigned char* ldsb;
    __device__ __forceinline__ void pre_issue(const Unit& u, RstdLoads& L) const { rstd_issue(rsp, bias + u.pn * BM, u, L); }
    __device__ __forceinline__ void pre_finish(const Unit& u, PG8_LAS unsigned char* lds, const RstdLoads& L) const { rstd_finish(u, lds, L); }
    __device__ __forceinline__ void operator()(const f32x4 (&acc)[2][2][4][2], const Unit& u, int wr, int wc, int fr_, int fq_) const {
        int lane_ = (int)__builtin_amdgcn_mbcnt_hi(~0u, __builtin_amdgcn_mbcnt_lo(~0u, 0u)); asm volatile("" : "+v"(lane_));
        const int fr = lane_ & 15, fq = lane_ >> 4; (void)fr_; (void)fq_;
        const int row0 = u.pm * BM + wr * 64 + fr, bcol0 = u.pn * BM + wc * 32 + 8 * fq, ocol0 = u.pn * HALF + wc * 32 + 8 * fq;
        float rs[8]; f32x4 bg[2], bu[2];
#pragma unroll
        for (int i = 0; i < 8; ++i) rs[i] = ((const PG8_LAS float*)(ldsb + RST_OFF))[u.par * 256 + wr * 64 + fr + (i >> 2) * HALF + (i & 3) * 16];
#pragma unroll
        for (int n = 0; n < 2; ++n) { const PG8_LAS float* bt = (const PG8_LAS float*)(ldsb + BIAS_OFF) + u.par * 256 + wc * 32 + 8 * fq + 4 * n; bg[n] = *(const PG8_LAS f32x4*)bt; bu[n] = *(const PG8_LAS f32x4*)(bt + HALF); }
#pragma unroll
        for (int ai = 0; ai < 2; ++ai)
#pragma unroll
            for (int m = 0; m < 4; ++m) { const int r = row0 + ai * HALF + m * 16; const float rsv = rs[ai * 4 + m];
                f32x4 h[2];
#pragma unroll
                for (int n = 0; n < 2; ++n) { const f32x4 g = acc[ai][0][m][n] * rsv + bg[n], up = acc[ai][1][m][n] * rsv + bu[n];
                    h[n] = (f32x4){fast_silu(g[0]) * up[0], fast_silu(g[1]) * up[1], fast_silu(g[2]) * up[2], fast_silu(g[3]) * up[3]}; }
                if constexpr (F8OUT) { u32x2 w; w.x = pk4_fp8(h[0][0] * HS8, h[0][1] * HS8, h[0][2] * HS8, h[0][3] * HS8); w.y = pk4_fp8(h[1][0] * HS8, h[1][1] * HS8, h[1][2] * HS8, h[1][3] * HS8);
                    *(u32x2*)((unsigned char*)O + (size_t)r * ldo + ocol0) = w; }
                else { u32x4 w; w.x = cvt_pk_bf16(h[0][0], h[0][1]); w.y = cvt_pk_bf16(h[0][2], h[0][3]); w.z = cvt_pk_bf16(h[1][0], h[1][1]); w.w = cvt_pk_bf16(h[1][2], h[1][3]);
                    *(u32x4*)(O + (size_t)r * ldo + ocol0) = w; } }
    }
};
struct EpiResid {
    static constexpr bool PERM = true, AFTER_DRAIN = false, PRE = false, MID = false; static constexpr int SA = E8_W, SB = E8_H;
    const float* xin; float* xout; bf16_t* xb; unsigned char* xb8; const float* gate; float* rsp_next; float wgt; int flags;
    __device__ __forceinline__ void operator()(const f32x4 (&acc)[2][2][4][2], const Unit& u, int wr, int wc, int fr_, int fq_) const {
        int lane_ = (int)__builtin_amdgcn_mbcnt_hi(~0u, __builtin_amdgcn_mbcnt_lo(~0u, 0u)); asm volatile("" : "+v"(lane_));
        const int fr = lane_ & 15, fq = lane_ >> 4; (void)fr_; (void)fq_;
        const int row0 = u.pm * BM + wr * 64 + fr, col0 = u.pn * BM + wc * 32 + 8 * fq;
#pragma unroll
        for (int hb = 0; hb < 4; ++hb) { f32x4 xv[2][2][2]; f32x4 gt[2][2];
#pragma unroll
            for (int bj = 0; bj < 2; ++bj)
#pragma unroll
                for (int n = 0; n < 2; ++n) gt[bj][n] = *(const f32x4*)(gate + col0 + bj * HALF + 4 * n) * wgt;
#pragma unroll
            for (int mm = 0; mm < 2; ++mm)
#pragma unroll
                for (int bj = 0; bj < 2; ++bj) { const size_t off = (size_t)(row0 + (hb >> 1) * HALF + ((hb & 1) * 2 + mm) * 16) * 2048 + col0 + bj * HALF; if (flags & 8) { const u32x4 w = *(const u32x4*)(xb + off); xv[mm][bj][0] = (f32x4){__uint_as_float(w.x << 16), __uint_as_float(w.x & 0xffff0000u), __uint_as_float(w.y << 16), __uint_as_float(w.y & 0xffff0000u)};
                        xv[mm][bj][1] = (f32x4){__uint_as_float(w.z << 16), __uint_as_float(w.z & 0xffff0000u), __uint_as_float(w.w << 16), __uint_as_float(w.w & 0xffff0000u)}; }
                    else { xv[mm][bj][0] = *(const f32x4*)(xin + off); xv[mm][bj][1] = *(const f32x4*)(xin + off + 4); } }
#pragma unroll
            for (int mm = 0; mm < 2; ++mm) { const int ai = hb >> 1, m = (hb & 1) * 2 + mm; const int r = row0 + ai * HALF + m * 16; float ss = 0.f;
#pragma unroll
                for (int bj = 0; bj < 2; ++bj) { const size_t off = (size_t)r * 2048 + col0 + bj * HALF;
                    const f32x4 x0 = xv[mm][bj][0] + gt[bj][0] * acc[ai][bj][m][0], x1 = xv[mm][bj][1] + gt[bj][1] * acc[ai][bj][m][1];
                    if (flags & 16) { *(f32x4*)(xout + off) = x0; *(f32x4*)(xout + off + 4) = x1; }
                    if (flags & 1) { u32x4 w; w.x = cvt_pk_bf16(x0[0], x0[1]); w.y = cvt_pk_bf16(x0[2], x0[3]); w.z = cvt_pk_bf16(x1[0], x1[1]); w.w = cvt_pk_bf16(x1[2], x1[3]);
                        *(u32x4*)(xb + off) = w; }
                    if (flags & 2) { u32x2 w; w.x = pk4_fp8(x0[0] * XS8, x0[1] * XS8, x0[2] * XS8, x0[3] * XS8); w.y = pk4_fp8(x1[0] * XS8, x1[1] * XS8, x1[2] * XS8, x1[3] * XS8);
                        *(u32x2*)(xb8 + off) = w; }
                    ss += (x0[0] * x0[0] + x0[1] * x0[1]) + (x0[2] * x0[2] + x0[3] * x0[3]) + (x1[0] * x1[0] + x1[1] * x1[1]) + (x1[2] * x1[2] + x1[3] * x1[3]); }
                ss += __shfl_xor(ss, 16); ss += __shfl_xor(ss, 32);
                if ((flags & 4) && fq == 0) rsp_next[(size_t)r * 32 + u.pn * 4 + wc] = ss; } }
    }
};
struct EpiMix {
    static constexpr bool PERM = true, AFTER_DRAIN = false, PRE = true, MID = false; static constexpr int SA = E8_W, SB = E8_X;
    bf16_t* O; const float* bias; const float* rsp; int ldo; int sig_tile; int coff; PG8_LAS unsigned char* ldsb;
    __device__ __forceinline__ void pre_issue(const Unit& u, RstdLoads& L) const { rstd_issue(rsp, bias + coff + u.pn * BM, u, L); }
    __device__ __forceinline__ void pre_finish(const Unit& u, PG8_LAS unsigned char* lds, const RstdLoads& L) const { rstd_finish(u, lds, L); }
    __device__ __forceinline__ void operator()(const f32x4 (&acc)[2][2][4][2], const Unit& u, int wr, int wc, int fr_, int fq_) const {
        int lane_ = (int)__builtin_amdgcn_mbcnt_hi(~0u, __builtin_amdgcn_mbcnt_lo(~0u, 0u)); asm volatile("" : "+v"(lane_));
        const int fr = lane_ & 15, fq = lane_ >> 4; (void)fr_; (void)fq_;
        const int row0 = u.pm * BM + wr * 64 + fr, col0 = coff + u.pn * BM + wc * 32 + 8 * fq; const bool sig = u.pn >= sig_tile;
        float rs[8]; f32x4 bv[2][2];
#pragma unroll
        for (int i = 0; i < 8; ++i) rs[i] = ((const PG8_LAS float*)(ldsb + RST_OFF))[u.par * 256 + wr * 64 + fr + (i >> 2) * HALF + (i & 3) * 16];
#pragma unroll
        for (int bj = 0; bj < 2; ++bj)
#pragma unroll
            for (int n = 0; n < 2; ++n) bv[bj][n] = *(const PG8_LAS f32x4*)((const PG8_LAS float*)(ldsb + BIAS_OFF) + u.par * 256 + wc * 32 + 8 * fq + bj * HALF + 4 * n);
#pragma unroll
        for (int ai = 0; ai < 2; ++ai)
#pragma unroll
            for (int m = 0; m < 4; ++m) { const int r = row0 + ai * HALF + m * 16; const float rsv = rs[ai * 4 + m];
#pragma unroll
                for (int bj = 0; bj < 2; ++bj) { f32x4 v0 = acc[ai][bj][m][0] * rsv + bv[bj][0], v1 = acc[ai][bj][m][1] * rsv + bv[bj][1];
                    if (sig) { v0 = (f32x4){fast_sigmoid(v0[0]), fast_sigmoid(v0[1]), fast_sigmoid(v0[2]), fast_sigmoid(v0[3])}; v1 = (f32x4){fast_sigmoid(v1[0]), fast_sigmoid(v1[1]), fast_sigmoid(v1[2]), fast_sigmoid(v1[3])}; }
                    u32x4 w; w.x = cvt_pk_bf16(v0[0], v0[1]); w.y = cvt_pk_bf16(v0[2], v0[3]); w.z = cvt_pk_bf16(v1[0], v1[1]); w.w = cvt_pk_bf16(v1[2], v1[3]);
                    *(u32x4*)(O + (size_t)r * ldo + col0 + bj * HALF) = w; } }
    }
};
struct EpiBrCat {
    static constexpr bool PERM = true, AFTER_DRAIN = false, PRE = false, MID = true; static constexpr int SA = 0, SB = 0, MID0 = 16, MID1 = 48;
    const bf16_t* ga; const bf16_t* gs; const bf16_t* gc; int ldg; bf16_t* outb;
    static __device__ __forceinline__ f32x4 gfloor(f32x4 v) { return (f32x4){fmaxf(v[0], 1e-20f), fmaxf(v[1], 1e-20f), fmaxf(v[2], 1e-20f), fmaxf(v[3], 1e-20f)}; }
    static __device__ __forceinline__ f32x4 rcp4(f32x4 v) { return (f32x4){__builtin_amdgcn_rcpf(v[0]), __builtin_amdgcn_rcpf(v[1]), __builtin_amdgcn_rcpf(v[2]), __builtin_amdgcn_rcpf(v[3])}; }
    __device__ __forceinline__ void mid(f32x4 (&acc)[2][2][4][2], const Unit& u, int seg, int wr, int wc) const {
        int lane_ = (int)__builtin_amdgcn_mbcnt_hi(~0u, __builtin_amdgcn_mbcnt_lo(~0u, 0u)); asm volatile("" : "+v"(lane_));
        const int fr = lane_ & 15, fq = lane_ >> 4; const int row0 = u.pm * BM + wr * 64 + fr, col0 = u.pn * BM + wc * 32 + 8 * fq;
        const bf16_t* gn = seg == 0 ? ga : gs; const bf16_t* gd = seg == 0 ? gs : gc;
#pragma unroll
        for (int ai = 0; ai < 2; ++ai) { u32x4 nv[4][2], dv[4][2];
#pragma unroll
            for (int m = 0; m < 4; ++m)
#pragma unroll
                for (int bj = 0; bj < 2; ++bj) { const int r = row0 + ai * HALF + m * 16; nv[m][bj] = *(const u32x4*)(gn + (size_t)r * ldg + col0 + bj * HALF); dv[m][bj] = *(const u32x4*)(gd + (size_t)r * ldg + col0 + bj * HALF); }
#pragma unroll
            for (int m = 0; m < 4; ++m)
#pragma unroll
                for (int bj = 0; bj < 2; ++bj) {
                    acc[ai][bj][m][0] = acc[ai][bj][m][0] * (gfloor(unpack_lo(nv[m][bj].x, nv[m][bj].y)) * rcp4(gfloor(unpack_lo(dv[m][bj].x, dv[m][bj].y))));
                    acc[ai][bj][m][1] = acc[ai][bj][m][1] * (gfloor(unpack_lo(nv[m][bj].z, nv[m][bj].w)) * rcp4(gfloor(unpack_lo(dv[m][bj].z, dv[m][bj].w)))); } }
    }
    __device__ __forceinline__ void operator()(const f32x4 (&acc)[2][2][4][2], const Unit& u, int wr, int wc, int fr_, int fq_) const {
        int lane_ = (int)__builtin_amdgcn_mbcnt_hi(~0u, __builtin_amdgcn_mbcnt_lo(~0u, 0u)); asm volatile("" : "+v"(lane_));
        const int fr = lane_ & 15, fq = lane_ >> 4; (void)fr_; (void)fq_;
        const int row0 = u.pm * BM + wr * 64 + fr, col0 = u.pn * BM + wc * 32 + 8 * fq;
        u32x4 gv[8][2];
#pragma unroll
        for (int i = 0; i < 8; ++i)
#pragma unroll
            for (int bj = 0; bj < 2; ++bj) gv[i][bj] = *(const u32x4*)(gc + (size_t)(row0 + (i >> 2) * HALF + (i & 3) * 16) * ldg + col0 + bj * HALF);
#pragma unroll
        for (int i = 0; i < 8; ++i) { const int ai = i >> 2, m = i & 3; const int r = row0 + ai * HALF + m * 16;
#pragma unroll
            for (int bj = 0; bj < 2; ++bj) { const size_t off = (size_t)r * 2048 + col0 + bj * HALF;
                const f32x4 v0 = acc[ai][bj][m][0] * gfloor(unpack_lo(gv[i][bj].x, gv[i][bj].y)), v1 = acc[ai][bj][m][1] * gfloor(unpack_lo(gv[i][bj].z, gv[i][bj].w));
                u32x4 w; w.x = cvt_pk_bf16(v0[0], v0[1]); w.y = cvt_pk_bf16(v0[2], v0[3]); w.z = cvt_pk_bf16(v1[0], v1[1]); w.w = cvt_pk_bf16(v1[2], v1[3]); *(u32x4*)(outb + off) = w; } }
    }
};

template <bool FP8> struct Frag { bf16x8 v[2]; };
template <> struct Frag<true> { i32x8 q; };
template <class Epi, class Sched, bool ALIGN_EPI = false, bool SP2 = false, bool FP8 = false>
__device__ __forceinline__ void gemm_phase(PG8_LAS unsigned char* lds, const Gemm g, const Sched& S, const Epi& E) {
    int tid_ = threadIdx.x; asm volatile("" : "+v"(tid_));
    const int tid = tid_, wid = __builtin_amdgcn_readfirstlane(tid >> 6), lane = tid & 63, wr = wid >> 2, wc = wid & 3, fr = lane & 15, fq = lane >> 4;
    const int K = g.K, nt = g.nt_probe > 0 ? g.nt_probe : K / BK;
    unsigned voffA[2], voffB[2];
#pragma unroll
    for (int i = 0; i < 2; ++i) { int R, C; stage_rc(tid * 16 + i * 8192, R, C); const int Rb = Epi::PERM ? ((R & ~31) + perm32(R & 31)) : R;
        voffA[i] = (unsigned)(R * K + C) * 2u; voffB[i] = (unsigned)(Rb * K + C) * 2u; }
    const size_t rstep64 = (size_t)64 * K * 2;
    const size_t kstep = (size_t)(BK * 2);
    const size_t hstep = (size_t)HALF * K * 2;
    const size_t tstep = 2 * hstep;
    const unsigned ldsw = (unsigned)wid * 1024u;
    const int aoff = lds_byte(wr * 64 + fr, fq * 8), boff = lds_byte(wc * 32 + fr, fq * 8);
    unsigned lda_ = (unsigned)(size_t)lds + (unsigned)aoff, ldb_ = (unsigned)(size_t)lds + 4u * HTB + (unsigned)boff; asm volatile("" : "+v"(lda_), "+v"(ldb_));
#define PG8_SA(b, h) (((b) * 2 + (h)) * HTB)
#define PG8_SB(b, h) ((4 + (b) * 2 + (h)) * HTB)
#define PG8_STAGE(bufoff, gbase, voff) do { _Pragma("unroll") for (int _i = 0; _i < 2; ++_i) \
        __builtin_amdgcn_global_load_lds((const unsigned*)((const char*)(gbase) + (size_t)_i * rstep64 + (voff)[0]), (PG8_LAS unsigned*)(lds + (bufoff) + ldsw + _i * 8192), 16, 0, 0); } while (0)
#define PG8_RA(b, h) (((b) * 2 + (h)) * HTB)
#define PG8_LDP(T, base, off) (*(const PG8_LAS T*)(PG8_LAS unsigned char*)(size_t)((base) + (unsigned)(off)))
#define PG8_LDA(dst, b, h) do { _Pragma("unroll") for (int m = 0; m < 4; ++m) { \
        if constexpr (FP8) dst[m].q = __builtin_shufflevector(PG8_LDP(i32x4, lda_, PG8_RA(b, h) + m * 2048), PG8_LDP(i32x4, lda_, PG8_RA(b, h) + m * 2048 + 1024), 0, 1, 2, 3, 4, 5, 6, 7); \
        else { _Pragma("unroll") for (int k = 0; k < 2; ++k) dst[m].v[k] = PG8_LDP(bf16x8, lda_, PG8_RA(b, h) + m * 2048 + k * 1024); } } } while (0)
#define PG8_LDB(dst, b, h) do { _Pragma("unroll") for (int n = 0; n < 2; ++n) { \
        if constexpr (FP8) dst[n].q = __builtin_shufflevector(PG8_LDP(i32x4, ldb_, PG8_RA(b, h) + n * 2048), PG8_LDP(i32x4, ldb_, PG8_RA(b, h) + n * 2048 + 1024), 0, 1, 2, 3, 4, 5, 6, 7); \
        else { _Pragma("unroll") for (int k = 0; k < 2; ++k) dst[n].v[k] = PG8_LDP(bf16x8, ldb_, PG8_RA(b, h) + n * 2048 + k * 1024); } } } while (0)
#ifndef PROBE_NOMMA
#define PROBE_NOMMA 0
#endif
#define PG8_MMA(ai, bj, At, Bt) do { if (PROBE_NOMMA && g.nt_probe > 0) break; __builtin_amdgcn_s_setprio(1); \
        if constexpr (FP8) { _Pragma("unroll") for (int m = 0; m < 4; ++m) _Pragma("unroll") for (int n = 0; n < 2; ++n) \
            { constexpr int dummy_ = 0; (void)dummy_; const int o_ = (m * 2 + n) * 4; \
              f32x4 c_ = (f32x4){accq[ai][bj][o_], accq[ai][bj][o_ + 1], accq[ai][bj][o_ + 2], accq[ai][bj][o_ + 3]}; \
              c_ = __builtin_amdgcn_mfma_scale_f32_16x16x128_f8f6f4(Bt[n].q, At[m].q, c_, 0, 0, 0, Epi::SA, 0, Epi::SB); \
              accq[ai][bj][o_] = c_[0]; accq[ai][bj][o_ + 1] = c_[1]; accq[ai][bj][o_ + 2] = c_[2]; accq[ai][bj][o_ + 3] = c_[3]; } } \
        else { _Pragma("unroll") for (int m = 0; m < 4; ++m) _Pragma("unroll") for (int n = 0; n < 2; ++n) _Pragma("unroll") for (int k = 0; k < 2; ++k) \
            acc[ai][bj][m][n] = __builtin_amdgcn_mfma_f32_16x16x32_bf16(Bt[n].v[k], At[m].v[k], acc[ai][bj][m][n], 0, 0, 0); } \
        __builtin_amdgcn_s_setprio(0); } while (0)
#define PG8_WAIT_V(n) asm volatile("s_waitcnt vmcnt(" #n ")" ::: "memory")
#define PG8_WAIT_L(n) asm volatile("s_waitcnt lgkmcnt(" #n ")" ::: "memory")
#define PG8_BAR __builtin_amdgcn_s_barrier()
#define PG8_SCHED __builtin_amdgcn_sched_barrier(0)
    Unit cur, nxt; int ui = 0;
    if (!S.next(0, cur)) return;
    f32x4 acc[2][2][4][2];
    f32x32 accq[2][2];
#pragma unroll
    for (int a = 0; a < 2; ++a)
#pragma unroll
        for (int b = 0; b < 2; ++b)
#pragma unroll
            for (int m = 0; m < 4; ++m)
#pragma unroll
                for (int n = 0; n < 2; ++n) { if constexpr (FP8) { _Pragma("unroll") for (int i_ = 0; i_ < 4; ++i_) accq[a][b][(m * 2 + n) * 4 + i_] = 0.f; } else acc[a][b][m][n] = (f32x4){0.f, 0.f, 0.f, 0.f}; }
    Frag<FP8> At[4], B0[2], B1[2];
    const char* cA = (const char*)g.A + (size_t)cur.pm * tstep; const char* cB = (const char*)g.Bt + (size_t)cur.pn * tstep;
    S.a_ready(cur);
    cur.par = 0;
    RstdLoads L0_; if constexpr (Epi::PRE) E.pre_issue(cur, L0_);
    if constexpr (SP2) {
        PG8_STAGE(PG8_SB(0, 0), cB, voffB); PG8_STAGE(PG8_SB(0, 1), cB + hstep, voffB); PG8_STAGE(PG8_SA(0, 0), cA, voffA); PG8_STAGE(PG8_SA(0, 1), cA + hstep, voffA);
        if (wr == 1) PG8_BAR;
        PG8_WAIT_V(2); PG8_BAR;
        PG8_STAGE(PG8_SB(1, 0), cB + kstep, voffB); PG8_STAGE(PG8_SA(1, 0), cA + kstep, voffA); PG8_STAGE(PG8_SB(1, 1), cB + hstep + kstep, voffB);
        PG8_WAIT_V(6); PG8_BAR;
    } else {
        PG8_STAGE(PG8_SB(0, 0), cB, voffB); PG8_STAGE(PG8_SA(0, 0), cA, voffA); PG8_STAGE(PG8_SB(0, 1), cB + hstep, voffB); PG8_STAGE(PG8_SA(0, 1), cA + hstep, voffA);
        if (wr == 1) PG8_BAR;
        PG8_WAIT_V(4); PG8_BAR;
        PG8_STAGE(PG8_SB(1, 0), cB + kstep, voffB); PG8_STAGE(PG8_SA(1, 0), cA + kstep, voffA); PG8_STAGE(PG8_SB(1, 1), cB + hstep + kstep, voffB);
        PG8_WAIT_V(6); PG8_BAR;
    }
    if constexpr (Epi::PRE) E.pre_finish(cur, lds, L0_);
    for (;;) {
        const bool has_next = S.next(ui + 1, nxt); nxt.par = (ui + 1) & 1;
        const char* nA = has_next ? (const char*)g.A + (size_t)nxt.pm * tstep : cA; const char* nB = has_next ? (const char*)g.Bt + (size_t)nxt.pn * tstep : cB;
        for (int t = 0; t < nt; t += 2) {
            if constexpr (Epi::MID) { static_assert(!FP8, "mid-loop accumulator hooks act on the bf16 path's accumulator array"); if (t == Epi::MID0) E.mid(acc, cur, 0, wr, wc); else if (t == Epi::MID1) E.mid(acc, cur, 1, wr, wc); }
            const bool last = (t == nt - 2);
            const char* a1 = cA + (size_t)(t + 1) * kstep;
            const char* a2 = last ? nA : cA + (size_t)(t + 2) * kstep; const char* b2 = last ? nB : cB + (size_t)(t + 2) * kstep;
            const char* a3 = a2 + kstep; const char* b3 = b2 + kstep;
            if (last && has_next) S.a_ready(nxt);
            if constexpr (SP2) {
            PG8_LDB(B0, 0, 0); PG8_LDB(B1, 0, 1); PG8_SCHED; PG8_LDA(At, 0, 0); PG8_STAGE(PG8_SA(1, 1), a1 + hstep, voffA);
            PG8_WAIT_V(8); PG8_WAIT_L(0); PG8_BAR; PG8_MMA(0, 0, At, B0); PG8_MMA(0, 1, At, B1); PG8_BAR; PG8_SCHED;
            PG8_LDA(At, 0, 1); PG8_STAGE(PG8_SB(0, 0), b2, voffB); PG8_STAGE(PG8_SB(0, 1), b2 + hstep, voffB); PG8_STAGE(PG8_SA(0, 0), a2, voffA);
            PG8_WAIT_V(8); PG8_WAIT_L(0); PG8_BAR; PG8_MMA(1, 0, At, B0); PG8_MMA(1, 1, At, B1); PG8_BAR; PG8_SCHED;
            PG8_LDB(B0, 1, 0); PG8_LDB(B1, 1, 1); PG8_SCHED; PG8_LDA(At, 1, 0); PG8_STAGE(PG8_SA(0, 1), a2 + hstep, voffA);
            PG8_WAIT_V(8); PG8_WAIT_L(0); PG8_BAR; PG8_MMA(0, 0, At, B0); PG8_MMA(0, 1, At, B1); PG8_BAR; PG8_SCHED;
            PG8_LDA(At, 1, 1); PG8_STAGE(PG8_SB(1, 0), b3, voffB); PG8_STAGE(PG8_SB(1, 1), b3 + hstep, voffB); PG8_STAGE(PG8_SA(1, 0), a3, voffA);
            PG8_WAIT_V(8); PG8_WAIT_L(0); PG8_BAR; PG8_MMA(1, 0, At, B0); PG8_MMA(1, 1, At, B1); PG8_BAR; PG8_SCHED;
            } else {
            PG8_LDB(B0, 0, 0); PG8_SCHED; PG8_LDA(At, 0, 0); PG8_STAGE(PG8_SA(1, 1), a1 + hstep, voffA);
            PG8_WAIT_L(8); PG8_BAR; PG8_WAIT_L(0); PG8_MMA(0, 0, At, B0); PG8_BAR; PG8_SCHED;
            PG8_LDB(B1, 0, 1); PG8_STAGE(PG8_SB(0, 0), b2, voffB);
            PG8_BAR; PG8_WAIT_L(0); PG8_MMA(0, 1, At, B1); PG8_BAR;
            PG8_LDA(At, 0, 1); PG8_STAGE(PG8_SA(0, 0), a2, voffA);
            PG8_BAR; PG8_WAIT_L(0); PG8_MMA(1, 0, At, B0); PG8_BAR; PG8_SCHED;
            PG8_STAGE(PG8_SB(0, 1), b2 + hstep, voffB);
            PG8_WAIT_V(6); PG8_BAR; PG8_MMA(1, 1, At, B1); PG8_BAR;
            PG8_LDB(B0, 1, 0); PG8_SCHED; PG8_LDA(At, 1, 0); PG8_STAGE(PG8_SA(0, 1), a2 + hstep, voffA);
            PG8_WAIT_L(8); PG8_BAR; PG8_WAIT_L(0); PG8_MMA(0, 0, At, B0); PG8_BAR; PG8_SCHED;
            PG8_LDB(B1, 1, 1); PG8_STAGE(PG8_SB(1, 0), b3, voffB);
            PG8_BAR; PG8_WAIT_L(0); PG8_MMA(0, 1, At, B1); PG8_BAR;
            PG8_LDA(At, 1, 1); PG8_STAGE(PG8_SA(1, 0), a3, voffA);
            PG8_BAR; PG8_WAIT_L(0); PG8_MMA(1, 0, At, B0); PG8_BAR; PG8_SCHED;
            PG8_STAGE(PG8_SB(1, 1), b3 + hstep, voffB);
            PG8_WAIT_V(6); PG8_BAR; PG8_MMA(1, 1, At, B1); PG8_BAR;
            }
        }
        if constexpr (ALIGN_EPI) { if (wr == 0) PG8_BAR; }
        if constexpr (FP8) { _Pragma("unroll") for (int a = 0; a < 2; ++a) _Pragma("unroll") for (int b = 0; b < 2; ++b) _Pragma("unroll") for (int m = 0; m < 4; ++m) _Pragma("unroll") for (int n = 0; n < 2; ++n) { const int o_ = (m * 2 + n) * 4;
            acc[a][b][m][n] = (f32x4){accq[a][b][o_], accq[a][b][o_ + 1], accq[a][b][o_ + 2], accq[a][b][o_ + 3]}; } }
        RstdLoads Lp_; if constexpr (Epi::PRE) { if (has_next) E.pre_issue(nxt, Lp_); }
        if constexpr (!Epi::AFTER_DRAIN) { E(acc, cur, wr, wc, fr, fq); S.done(cur); }
        if constexpr (Epi::PRE) { if (has_next) E.pre_finish(nxt, lds, Lp_); }
        if (!has_next) break;
#pragma unroll
        for (int a = 0; a < 2; ++a)
#pragma unroll
            for (int b = 0; b < 2; ++b)
#pragma unroll
                for (int m = 0; m < 4; ++m)
#pragma unroll
                    for (int n = 0; n < 2; ++n) { if constexpr (FP8) { _Pragma("unroll") for (int i_ = 0; i_ < 4; ++i_) accq[a][b][(m * 2 + n) * 4 + i_] = 0.f; } else acc[a][b][m][n] = (f32x4){0.f, 0.f, 0.f, 0.f}; }
        cur = nxt; cA = nA; cB = nB; ++ui;
        if constexpr (ALIGN_EPI) { if (wr == 1) PG8_BAR; }
    }
    PG8_WAIT_V(0);
    if constexpr (!ALIGN_EPI) { if (wr == 0) PG8_BAR; }
    PG8_BAR;
    if constexpr (Epi::AFTER_DRAIN) { E.fused(acc, cur, wr, wc, fr, fq, lds, wid, lane); S.done(cur); }
#undef PG8_SA
#undef PG8_SB
#undef PG8_STAGE
#undef PG8_LDA
#undef PG8_LDB
#undef PG8_LDP
#undef PG8_RA
#undef PG8_MMA
#undef PG8_WAIT_V
#undef PG8_WAIT_L
#undef PG8_BAR
#undef PG8_SCHED
}
}

#define GAS __attribute__((address_space(1)))
#define LAS __attribute__((address_space(3)))
typedef unsigned short bf16;
typedef unsigned v4u __attribute__((ext_vector_type(4)));
typedef float f32x4 __attribute__((ext_vector_type(4)));
typedef short bf16x8 __attribute__((ext_vector_type(8)));
typedef GAS unsigned gu32;
typedef GAS unsigned long long gu64;
#define RLX_AGENT __ATOMIC_RELAXED, __HIP_MEMORY_SCOPE_AGENT
#define LDS_WAIT() asm volatile("s_waitcnt lgkmcnt(0)" ::: "memory")
#define VM_WAIT() asm volatile("s_waitcnt vmcnt(0)" ::: "memory")
__device__ __forceinline__ unsigned long long rt() { return __builtin_amdgcn_s_memrealtime(); }
__device__ __forceinline__ unsigned f2bf(float f) { unsigned u = __builtin_bit_cast(unsigned, f); return (u + 0x7fffu + ((u >> 16) & 1u)) >> 16; }
__device__ __forceinline__ unsigned pk2(float lo, float hi) { return f2bf(lo) | (f2bf(hi) << 16); }

#define XB_TMO      128
#define XB_XCNT(j)  (256  + 64 * (j))
#define XB_XSUB(j)  (1280 + 64 * (j))
#define XB_XGEN(j)  (2304 + 64 * (j))
#define XB_TOP      3328
#define XB_TOPGEN   3392
#define XCD_BAR_WORDS 3456
#define XB_SPIN_CAP (1u << 18)

__device__ __forceinline__ unsigned xb_ld(unsigned* p)              { return __hip_atomic_load(p, __ATOMIC_RELAXED, __HIP_MEMORY_SCOPE_AGENT); }
__device__ __forceinline__ unsigned xb_add(unsigned* p, unsigned v) { return __hip_atomic_fetch_add(p, v, __ATOMIC_RELAXED, __HIP_MEMORY_SCOPE_AGENT); }
__device__ __forceinline__ unsigned xb_xcc_id() { return (unsigned)__builtin_amdgcn_s_getreg((3 << 11) | 20) & 0xFu; }
#define XB_SPIN(cond, bar) do { unsigned _sp = 0; while (cond) { __builtin_amdgcn_s_sleep(1); \
    if ((++_sp & 255u) == 0u) { if (xb_ld(&(bar)[XB_TMO])) break; if (_sp > XB_SPIN_CAP) { atomicAdd(&(bar)[XB_TMO], 1u); break; } } } } while (0)

struct XcdBarrier {
    unsigned* bar; unsigned x;
    volatile LAS unsigned* st;
};

__device__ __forceinline__ XcdBarrier xcd_barrier_post(unsigned* bar, volatile LAS unsigned* st) {
    XcdBarrier b; b.bar = bar; b.x = xb_xcc_id(); b.st = st;
    if (threadIdx.x == 0) (void)xb_add(&bar[XB_XCNT(b.x)], 1u);
    return b;
}
__device__ __forceinline__ void xcd_barrier_complete(unsigned* bar, unsigned x, unsigned& nloc, unsigned& nx) {
    const unsigned G = gridDim.x * gridDim.y * gridDim.z;
    unsigned sum, cnt, mine, sp = 0u;
    for (;;) {
        sum = 0u; cnt = 0u; mine = 0u;
#pragma unroll
        for (unsigned j = 0; j < 16; ++j) { const unsigned c = xb_ld(&bar[XB_XCNT(j)]); sum += c; cnt += (c > 0u) ? 1u : 0u; mine = (j == x) ? c : mine; }
        if (sum == G) break;
        __builtin_amdgcn_s_sleep(1);
        if ((++sp & 255u) == 0u) { if (xb_ld(&bar[XB_TMO])) break; if (sp > XB_SPIN_CAP) { atomicAdd(&bar[XB_TMO], 1u); break; } }
    }
    nloc = mine > 0u ? mine : 1u; nx = cnt > 0u ? cnt : 1u;
}

__device__ __forceinline__ void xcd_barrier(const XcdBarrier& b) {
    asm volatile("s_waitcnt vmcnt(0)" ::: "memory");
    __syncthreads();
    if (threadIdx.x == 0) {
        unsigned* bar = b.bar;
        __builtin_amdgcn_s_waitcnt(0);
        unsigned nloc = b.st[0], nx = b.st[1];
        if (nloc == 0u) { xcd_barrier_complete(bar, b.x, nloc, nx); b.st[0] = nloc; b.st[1] = nx; }
        const unsigned old = xb_add(&bar[XB_XSUB(b.x)], 1u);
        const unsigned gen = old / nloc;
        if (old + 1u == (gen + 1u) * nloc) {
            __builtin_amdgcn_fence(__ATOMIC_RELEASE, "agent");
            asm volatile("s_waitcnt vmcnt(0)" ::: "memory");
            const unsigned og = xb_add(&bar[XB_TOP], 1u);
            const unsigned tg = og / nx;
            if (og + 1u == (tg + 1u) * nx) xb_add(&bar[XB_TOPGEN], 1u);
            else XB_SPIN(xb_ld(&bar[XB_TOPGEN]) == tg, bar);
            __builtin_amdgcn_fence(__ATOMIC_ACQUIRE, "agent");
            xb_add(&bar[XB_XGEN(b.x)], 1u);
            asm volatile("s_waitcnt vmcnt(0)" ::: "memory");
        } else {
            XB_SPIN(xb_ld(&bar[XB_XGEN(b.x)]) == gen, bar);
            __builtin_amdgcn_fence(__ATOMIC_ACQUIRE, "agent");
            asm volatile("s_waitcnt vmcnt(0)" ::: "memory");
        }
    }
    __syncthreads();
}

constexpr int S_ = 8192, DM = 2048, FF = 5632, FF2 = 11264, NMIX = 17664, NMIXSRC = 17440, NADA = 18432;
constexpr int AH = 8, AW = 1024, NBLK = 32;
constexpr int SH = 32, SGRP = 4, XBCW = 3072, NCH = 32;
constexpr int CWID = 1024;
constexpr int MC_Q = 0, MC_K = 1024, MC_V = 2048, MC_Z = 3072, MC_XBC = 5120, MC_DT = 8192, MC_CB = 8448, MC_CC = 9472, MC_CX = 10496, MC_GA = 11520, MC_GS = 13568, MC_GC = 15616;
constexpr float LOG2E = 1.4426950408889634f;
constexpr float QSCALE = 0.08838834764831845f * 1.4426950408889634f;
constexpr float EPS = 1e-6f;

#ifndef STREAM_BF16
#define STREAM_BF16 1
#endif
#ifndef MIX_GATE_FP8
#define MIX_GATE_FP8 1
#endif
#ifndef LAST_FFN_FP8
#define LAST_FFN_FP8 1
#endif
constexpr size_t KiB = 1024, MiB = 1u << 20;
constexpr size_t WS_CTL = 0;
constexpr size_t WS_CNT = 64 * KiB;
constexpr int CNT_STRIDE = 32;
constexpr size_t ZERO_BYTES = 128 * KiB;
static_assert(WS_CNT + 2 * 8 * 32 * CNT_STRIDE * 4 <= ZERO_BYTES && (4096 + 3456) * 4 <= WS_CNT, "zero region");
constexpr size_t WS_ADA = 128 * KiB;
constexpr size_t WS_GK = WS_ADA + 2 * NADA * 4;
constexpr size_t WS_RSTD = WS_GK + 6 * 2048 * 4;
constexpr size_t WS_BIASIN = 352 * KiB;
constexpr size_t WS_BIASMIX = WS_BIASIN + 4 * FF2 * 4;
constexpr int BIAS_Q = 4; constexpr size_t BIAS_QS = 336 * KiB; constexpr int BIAS_QF = (int)(BIAS_QS / 4);
static_assert(WS_RSTD + S_ * 4 <= WS_BIASIN && WS_BIASMIX + 2 * NMIX * 4 <= WS_BIASIN + BIAS_QS && WS_BIASIN + BIAS_Q * BIAS_QS <= 2 * MiB, "bias partials");
static_assert(pg8::PG8_BIAS_QF == BIAS_QF, "epilogues and workspace map agree on the partial-bias stride");
static_assert(WS_RSTD + S_ * 4 <= 2 * MiB, "small vectors");
constexpr size_t WS_KMEAN = 2 * MiB;
constexpr size_t WS_LUT = WS_KMEAN + 8 * 32 * 128 * 4;
constexpr size_t WS_ACST = 3 * MiB;
constexpr size_t WS_ML = 4 * MiB;
constexpr size_t WS_LIST = 6 * MiB;
constexpr size_t WS_RSP = 14 * MiB;
constexpr size_t WS_GSP = 15 * MiB;
constexpr size_t WS_W = 16 * MiB;
constexpr size_t W_IN = 0, W_IN_SZ = (size_t)FF2 * DM * 2;
constexpr size_t W_OUT = W_IN + 2 * W_IN_SZ, W_OUT_SZ = (size_t)DM * FF * 2;
constexpr size_t W_MIX = W_OUT + 2 * W_OUT_SZ, W_MIX_SZ = (size_t)NMIX * DM * 2;
constexpr size_t W_BA = W_MIX + W_MIX_SZ, W_BS = W_BA + (size_t)DM * 1024 * 2, W_BC = W_BS + (size_t)DM * 2048 * 2, W_MO = W_BC + (size_t)DM * 1024 * 2;
constexpr size_t LAYER_W = W_MO + (size_t)DM * DM * 2;
constexpr size_t WS_XB = WS_W + 2 * LAYER_W;
constexpr size_t WS_XB8 = WS_XB + (size_t)S_ * DM * 2;
constexpr size_t WS_ACT = WS_XB8 + (size_t)S_ * DM;
constexpr size_t A_HID = WS_ACT;
constexpr size_t A_MIX = WS_ACT;
constexpr size_t A_QN = A_MIX + (size_t)S_ * NMIX * 2;
constexpr size_t A_KN = A_QN + (size_t)S_ * AW * 2;
constexpr size_t A_XC = A_KN + (size_t)S_ * AW * 2;
constexpr size_t A_XDT = A_XC + (size_t)S_ * XBCW * 2;
constexpr size_t A_BT = A_XDT + (size_t)2048 * S_ * 2;
constexpr size_t A_STATES = A_BT + (size_t)512 * S_ * 2;
constexpr size_t A_PREV = A_STATES + (size_t)NCH * SH * 64 * 128 * 4;
constexpr size_t A_CBM = A_PREV + (size_t)NCH * SH * 64 * 128 * 2;
constexpr size_t A_YCAT = A_CBM + (size_t)NCH * SGRP * 256 * 256 * 2;
constexpr int YCAT_LD = 4096, YC_ATTN = 0, YC_SSD = 1024, YC_CONV = 3072;
constexpr size_t A_PART = A_YCAT + (size_t)S_ * YCAT_LD * 2;
constexpr size_t WS_END = A_PART + (size_t)4 * S_ * AW * 2;
constexpr size_t A_MRG = A_XDT;
static_assert(A_MRG + (size_t)S_ * DM * 2 <= A_BT, "overlays");
static_assert(WS_END <= (size_t)1200 * MiB, "workspace map must stay under the guaranteed scratch size");
static_assert(A_HID + (size_t)S_ * FF * 2 <= A_QN, "HID overlays MIX only");
constexpr int CW_BAR = 4096;

constexpr int RING_BYTES = 131072;
constexpr int SCR_OFF = RING_BYTES, SCR_BYTES = 24576;
constexpr int MISC_OFF = SCR_OFF + SCR_BYTES;
constexpr int LDS_BYTES = 156672;
static_assert(MISC_OFF + 256 <= LDS_BYTES, "LDS map");
constexpr int NWAVES = 8;


typedef float f32x16 __attribute__((ext_vector_type(16)));
typedef float f32x2 __attribute__((ext_vector_type(2)));
typedef short s16x4 __attribute__((ext_vector_type(4)));
struct Ctx {
    unsigned char* lds;
    int tid, lane, wave, G, bid;
    const float* in[21];
    float* out; unsigned char* ws;
};
enum { IN_X = 0, IN_C, IN_WADA, IN_BADA, IN_GAIN, IN_WFFIN, IN_WFFOUT, IN_WMIX, IN_QKN, IN_RELB, IN_WSCONV, IN_BSCONV, IN_DTB, IN_ALOG, IN_SSDD, IN_SSDN, IN_WSC, IN_WBA, IN_WBS, IN_WBC, IN_WMO };

__device__ __forceinline__ float wave_sum(float v) {
#pragma unroll
    for (int o = 1; o < 64; o <<= 1) v += __shfl_xor(v, o);
    return v;
}
__device__ __forceinline__ float bf2f(bf16 b) { return __uint_as_float((unsigned)b << 16); }
__device__ __forceinline__ unsigned cvtpk(float lo, float hi) { unsigned r; asm volatile("v_cvt_pk_bf16_f32 %0, %1, %2" : "=v"(r) : "v"(lo), "v"(hi)); return r; }
#define UNPACK8(V_, f) do { const v4u u8_ = (V_); f[0] = __uint_as_float(u8_.x << 16); f[1] = __uint_as_float(u8_.x & 0xffff0000u); f[2] = __uint_as_float(u8_.y << 16); f[3] = __uint_as_float(u8_.y & 0xffff0000u); \
                           f[4] = __uint_as_float(u8_.z << 16); f[5] = __uint_as_float(u8_.z & 0xffff0000u); f[6] = __uint_as_float(u8_.w << 16); f[7] = __uint_as_float(u8_.w & 0xffff0000u); } while (0)
#define PACK8(f) ((v4u){cvtpk(f[0], f[1]), cvtpk(f[2], f[3]), cvtpk(f[4], f[5]), cvtpk(f[6], f[7])})
__device__ __forceinline__ int crow(int r, int hi) { return (r & 3) + 8 * (r >> 2) + 4 * hi; }
__device__ __forceinline__ float silu_f(float v) { return v * __builtin_amdgcn_rcpf(1.0f + __expf(-v)); }

__device__ __forceinline__ void ph_ada(const Ctx& C) {
    const float* cvec = C.in[IN_C]; const float* W = C.in[IN_WADA]; const float* b = C.in[IN_BADA];
    float* ada = (float*)(C.ws + WS_ADA); f32x4* red = (f32x4*)C.lds;
    for (int it = C.bid; it < 256; it += C.G) {
        const int l = it >> 7, j = (it & 127) * 144 + C.lane * 4, k0 = C.wave * 256;
        f32x4 acc = (f32x4){0.f, 0.f, 0.f, 0.f};
        if (C.lane < 36) { const float* Wp = W + ((size_t)l * 2048 + k0) * NADA + j;
#pragma unroll 16
            for (int kk = 0; kk < 256; ++kk) { const float cv = cvec[k0 + kk]; const float s = silu_f(cv); const f32x4 w = *(const f32x4*)(Wp + (size_t)kk * NADA); acc = acc + w * s; }
            red[C.wave * 36 + C.lane] = acc; }
        __syncthreads();
        if (C.tid < 36) { f32x4 t = *(const f32x4*)(b + l * NADA + j);
#pragma unroll
            for (int w = 0; w < 8; ++w) t = t + red[w * 36 + C.tid];
            *(f32x4*)(ada + l * NADA + j) = t;
            const int jj = (it & 127) * 144 + C.tid * 4, sub = jj / 6144, kind = (jj / 2048) % 3, d = jj & 2047;
            if (kind == 1) { const f32x4 g = *(const f32x4*)(C.in[IN_GAIN] + (l * 3 + sub) * 2048 + d); *(f32x4*)((float*)(C.ws + WS_GK) + (l * 3 + sub) * 2048 + d) = g * (t + 1.0f); } }
        __syncthreads();
    }
}

template <bool F8> __device__ __forceinline__ void tr_item(const float* W, int K, int N, int kb0, int nkb, int n0, bf16* WT, int drow0, const float* gk, const float* sh, float* bias, LAS float* scr, int lane, int dpitch = 0, int dk0 = 0) {
    if (dpitch == 0) dpitch = K;
    const int kr = lane >> 3, nc = (lane & 7) * 4;
    const float* Wp = W + (size_t)(64 * kb0 + kr) * N + n0 + nc;
    f32x4 bacc = (f32x4){0.f, 0.f, 0.f, 0.f};
    f32x4 cur[8], nx1[8];
#pragma unroll
    for (int i = 0; i < 8; ++i) cur[i] = *(const f32x4*)(Wp + (size_t)(8 * i) * N);
#pragma unroll
    for (int i = 0; i < 8; ++i) nx1[i] = nkb > 1 ? *(const f32x4*)(Wp + (size_t)(64 + 8 * i) * N) : cur[i];
    for (int kb = kb0; kb < kb0 + nkb; ++kb) { const int k0 = 64 * kb;
        f32x4 nx2[8];
        if (kb + 2 < kb0 + nkb) {
#pragma unroll
            for (int i = 0; i < 8; ++i) nx2[i] = *(const f32x4*)(Wp + (size_t)(64 * (kb + 2 - kb0) + 8 * i) * N); }
        else {
#pragma unroll
            for (int i = 0; i < 8; ++i) nx2[i] = cur[i]; }
#pragma unroll
        for (int i = 0; i < 8; ++i) { const int kk = 8 * i + kr, k = k0 + kk; f32x4 v = cur[i];
            if (sh) bacc = bacc + v * sh[k];
            if (gk) v = v * gk[k];
            LAS float* d = scr + kk * 33 + nc; d[0] = v[0]; d[1] = v[1]; d[2] = v[2]; d[3] = v[3]; }
        LDS_WAIT(); asm volatile("" ::: "memory");
        const int c = lane & 7;
#pragma unroll
        for (int j = 0; j < 4; ++j) { const int n = (lane >> 3) + 8 * j; const LAS float* s = scr + (8 * c) * 33 + n;
            if constexpr (F8) { pg8::u32x2 o; o.x = pg8::pk4_fp8(s[0 * 33] * pg8::WS8, s[1 * 33] * pg8::WS8, s[2 * 33] * pg8::WS8, s[3 * 33] * pg8::WS8); o.y = pg8::pk4_fp8(s[4 * 33] * pg8::WS8, s[5 * 33] * pg8::WS8, s[6 * 33] * pg8::WS8, s[7 * 33] * pg8::WS8);
                *(GAS pg8::u32x2*)((unsigned char*)WT + (size_t)(drow0 + n) * dpitch + dk0 + k0 + 8 * c) = o; }
            else { v4u o; o.x = pk2(s[0 * 33], s[1 * 33]); o.y = pk2(s[2 * 33], s[3 * 33]); o.z = pk2(s[4 * 33], s[5 * 33]); o.w = pk2(s[6 * 33], s[7 * 33]);
                *(GAS v4u*)(WT + (size_t)(drow0 + n) * dpitch + dk0 + k0 + 8 * c) = o; } }
        LDS_WAIT(); asm volatile("" ::: "memory");
#pragma unroll
        for (int i = 0; i < 8; ++i) { cur[i] = nx1[i]; nx1[i] = nx2[i]; } }
    if (sh) {
#pragma unroll
        for (int e = 0; e < 4; ++e) { float b = bacc[e]; b += __shfl_xor(b, 8); b += __shfl_xor(b, 16); b += __shfl_xor(b, 32); bacc[e] = b; }
        if (lane < 8) *(f32x4*)(bias + drow0 + nc) = bacc; }
}
__device__ __forceinline__ void ph_convert(const Ctx& C) {
    LAS float* scr = (LAS float*)((LAS unsigned char*)C.lds + C.wave * 16384);
    const int gw = C.bid * NWAVES + C.wave, NGW = C.G * NWAVES;
    const float* ada = (const float*)(C.ws + WS_ADA);
    constexpr int I_IN = FF2 / 32, I_MIX = NMIXSRC / 32;
    constexpr int I_LAYER = 2 * I_IN + I_MIX;
    for (int it4 = gw; it4 < BIAS_Q * 2 * I_LAYER; it4 += NGW) {
        const int it = it4 >> 2, kq = it4 & 3, kb0 = 8 * kq; const int bq = kq * BIAS_QF;
        const int l = it / I_LAYER; int r = it - l * I_LAYER;
        unsigned char* wl = C.ws + WS_W + (size_t)l * LAYER_W;
        const float* adal = ada + l * NADA; const float* gkl = (const float*)(C.ws + WS_GK) + l * 3 * 2048;
        if (r < 2 * I_IN) { const int f = r / I_IN; r -= f * I_IN; const int sub = f * 2;
            const int n0 = 32 * r;
            const int bj = n0 / FF, j = n0 - bj * FF, drow0 = (j / 128) * 256 + bj * 128 + (j % 128);
            if (LAST_FFN_FP8 && l == 1 && f == 1) tr_item<true>(C.in[IN_WFFIN] + (size_t)(l * 2 + f) * DM * FF2, DM, FF2, kb0, 8, n0, (bf16*)(wl + W_IN + f * W_IN_SZ), drow0,
                    gkl + sub * 2048, adal + (sub * 3 + 0) * 2048, (float*)(C.ws + WS_BIASIN) + bq + (l * 2 + f) * FF2, scr, C.lane);
            else tr_item<false>(C.in[IN_WFFIN] + (size_t)(l * 2 + f) * DM * FF2, DM, FF2, kb0, 8, n0, (bf16*)(wl + W_IN + f * W_IN_SZ), drow0,
                    gkl + sub * 2048, adal + (sub * 3 + 0) * 2048, (float*)(C.ws + WS_BIASIN) + bq + (l * 2 + f) * FF2, scr, C.lane);
            continue; }
        r -= 2 * I_IN;
        if (r < I_MIX) { const int n0 = 32 * r; const int drow0 = n0 < 8224 ? n0 : n0 + 224;
            if (MIX_GATE_FP8 && l == 1 && drow0 >= MC_GA) { tr_item<true>(C.in[IN_WMIX] + (size_t)l * DM * NMIXSRC, DM, NMIXSRC, kb0, 8, n0, (bf16*)(wl + W_MIX + (size_t)MC_GA * DM * 2), drow0 - MC_GA,
                    gkl + 1 * 2048, adal + (1 * 3 + 0) * 2048, (float*)(C.ws + WS_BIASMIX) + bq + l * NMIX + MC_GA, scr, C.lane); continue; }
            tr_item<false>(C.in[IN_WMIX] + (size_t)l * DM * NMIXSRC, DM, NMIXSRC, kb0, 8, n0, (bf16*)(wl + W_MIX), drow0,
                    gkl + 1 * 2048, adal + (1 * 3 + 0) * 2048, (float*)(C.ws + WS_BIASMIX) + bq + l * NMIX, scr, C.lane);
            continue; }
    }
    for (int it = gw; it < 2 * 224; it += NGW) { const int l = it / 224, row = 8224 + it % 224; GAS v4u* p = (GAS v4u*)(C.ws + WS_W + (size_t)l * LAYER_W + W_MIX + (size_t)row * DM * 2);
#pragma unroll
        for (int j = 0; j < 4; ++j) p[C.lane + 64 * j] = (v4u){0u, 0u, 0u, 0u};
        if (C.lane < BIAS_Q) ((float*)(C.ws + WS_BIASMIX))[C.lane * BIAS_QF + l * NMIX + row] = 0.f; }
    { const float* x = C.in[IN_X]; unsigned char* XB8 = C.ws + WS_XB8; float* rsp = (float*)(C.ws + WS_RSP);
      for (int m = gw; m < S_; m += NGW) { const GAS f32x4* xr = (const GAS f32x4*)(x + (size_t)m * DM) + C.lane; float ss = 0.f;
          GAS unsigned* o4 = (GAS unsigned*)((unsigned char*)XB8 + (size_t)m * DM) + C.lane; GAS unsigned long long* o8 = (GAS unsigned long long*)((bf16*)(C.ws + WS_XB) + (size_t)m * DM) + C.lane;
#pragma unroll
          for (int j = 0; j < 8; ++j) { const f32x4 v = xr[64 * j]; ss += (v.x * v.x + v.y * v.y) + (v.z * v.z + v.w * v.w);
              (void)o4; o8[64 * j] = (unsigned long long)pk2(v.x, v.y) | ((unsigned long long)pk2(v.z, v.w) << 32); }
          ss = wave_sum(ss); if (C.lane < 32) rsp[(size_t)m * 32 + C.lane] = C.lane == 0 ? ss : 0.f; } }
    if (C.bid == 0) { float* lut = (float*)(C.ws + WS_LUT); const float* rb = C.in[IN_RELB];
        for (int i = C.tid; i < 8 * 129; i += NWAVES * 64) { const int h = i / 129, d = i % 129; int bk;
            if (d < 16) bk = d; else { const float ratio = logf((float)d / 16.0f) / 2.0794415416798357f; bk = 16 + (int)(ratio * 16.0f); if (bk > 31) bk = 31; }
            lut[h * 132 + d] = rb[bk * 8 + h] * LOG2E; } }
}


__device__ __forceinline__ void convert_tail(const Ctx& C, int l, int what, int iw, int niw) {
    LAS float* scr = (LAS float*)((LAS unsigned char*)C.lds + C.wave * 16384);
    unsigned char* wl = C.ws + WS_W + (size_t)l * LAYER_W;
    if (what != 1) { const int f = what >> 1;
        for (int it = iw; it < 22 * 64; it += niw) { const int kr = it >> 6, n0 = 32 * (it & 63);
            if (LAST_FFN_FP8 && l == 1 && f == 1) tr_item<true>(C.in[IN_WFFOUT] + (size_t)(l * 2 + f) * FF * DM, FF, DM, 4 * kr, 4, n0, (bf16*)(wl + W_OUT + f * W_OUT_SZ), n0, nullptr, nullptr, nullptr, scr, C.lane);
            else tr_item<false>(C.in[IN_WFFOUT] + (size_t)(l * 2 + f) * FF * DM, FF, DM, 4 * kr, 4, n0, (bf16*)(wl + W_OUT + f * W_OUT_SZ), n0, nullptr, nullptr, nullptr, scr, C.lane); }
        return; }
    for (int it = iw; it < 1536; it += niw) {
        if (it < 256) { const int kr = it >> 6, n0 = 32 * (it & 63); tr_item<false>(C.in[IN_WBA] + (size_t)l * 1024 * DM, 1024, DM, 4 * kr, 4, n0, (bf16*)(wl + W_BA), n0, nullptr, nullptr, nullptr, scr, C.lane, YCAT_LD, YC_ATTN); }
        else if (it < 768) { const int r = it - 256, kr = r >> 6, n0 = 32 * (r & 63);
            tr_item<false>(C.in[IN_WBS] + (size_t)l * 2048 * DM, 2048, DM, 4 * kr, 4, n0, (bf16*)(wl + W_BA), n0, C.in[IN_SSDN] + l * 2048, nullptr, nullptr, scr, C.lane, YCAT_LD, YC_SSD); }
        else if (it < 1024) { const int r = it - 768, kr = r >> 6, n0 = 32 * (r & 63); tr_item<false>(C.in[IN_WBC] + (size_t)l * 1024 * DM, 1024, DM, 4 * kr, 4, n0, (bf16*)(wl + W_BA), n0, nullptr, nullptr, nullptr, scr, C.lane, YCAT_LD, YC_CONV); }
        else { const int r = it - 1024, kr = r >> 6, n0 = 32 * (r & 63); tr_item<false>(C.in[IN_WMO] + (size_t)l * DM * DM, DM, DM, 4 * kr, 4, n0, (bf16*)(wl + W_MO), n0, nullptr, nullptr, nullptr, scr, C.lane); }
    }
}
__device__ __forceinline__ void tail_waves(const Ctx& C, int nunits, int& iw, int& niw) {
    const int rounds = (nunits + C.G - 1) / C.G, cut = nunits - (rounds - 1) * C.G;
    if (cut >= C.G) { iw = C.bid * NWAVES + C.wave; niw = C.G * NWAVES; }
    else if (C.bid >= cut) { iw = (C.bid - cut) * NWAVES + C.wave; niw = (C.G - cut) * NWAVES; }
    else { iw = 0; niw = 0; }
}

#define PREP_BAR() do { asm volatile("s_waitcnt lgkmcnt(0)" ::: "memory"); __builtin_amdgcn_s_barrier(); asm volatile("" ::: "memory"); } while (0)
__device__ __forceinline__ void prep_qk_load(const Ctx& C, int u, v4u (&wq)[8]) {
    const int c = u >> 4, h = (u >> 1) & 7, which = u & 1; const bf16* MIX = (const bf16*)(C.ws + A_MIX); const int l16 = C.tid & 15, rsub = C.tid >> 4;
#pragma unroll
    for (int ps = 0; ps < 8; ++ps) wq[ps] = *(const v4u*)(MIX + (size_t)(256 * c + ps * 32 + rsub) * NMIX + which * 1024 + h * 128 + l16 * 8);
}
__device__ __forceinline__ void prep_qk_unit(const Ctx& C, int l, int u, const v4u (&wq)[8], bool hn, int un, v4u (&nq)[8]) {
    const int c = u >> 4, h = (u >> 1) & 7, which = u & 1;
    bf16* dst = (bf16*)(C.ws + (which ? A_KN : A_QN));
    const float* gn = C.in[IN_QKN] + (l * 2 + which) * 128;
    const int l16 = C.tid & 15, rsub = C.tid >> 4;
    float g[8];
#pragma unroll
    for (int e = 0; e < 8; ++e) g[e] = gn[l16 * 8 + e] * (which ? 1.0f : QSCALE);
    if (hn) prep_qk_load(C, un, nq);
    float cs[8];
#pragma unroll
    for (int e = 0; e < 8; ++e) cs[e] = 0.f;
#pragma unroll
    for (int ps = 0; ps < 8; ++ps) { const int r = 256 * c + ps * 32 + rsub;
        const v4u w = wq[ps];
        float f[8]; UNPACK8(w, f); float ss = 0.f;
#pragma unroll
        for (int e = 0; e < 8; ++e) ss += f[e] * f[e];
        ss += __shfl_xor(ss, 1); ss += __shfl_xor(ss, 2); ss += __shfl_xor(ss, 4); ss += __shfl_xor(ss, 8);
        const float rs = rsqrtf(ss * (1.0f / 128.0f) + EPS);
#pragma unroll
        for (int e = 0; e < 8; ++e) { f[e] = f[e] * rs * g[e]; cs[e] += f[e]; }
        *(v4u*)(dst + (size_t)r * AW + h * 128 + l16 * 8) = PACK8(f); }
    if (which) {
        float* scr = (float*)(C.lds);
#pragma unroll
        for (int e = 0; e < 8; ++e) { cs[e] += __shfl_xor(cs[e], 16); cs[e] += __shfl_xor(cs[e], 32); }
        if (C.lane < 16) {
#pragma unroll
            for (int e = 0; e < 8; ++e) scr[C.wave * 128 + l16 * 8 + e] = cs[e]; }
        PREP_BAR();
        if (C.tid < 128) { float s = 0.f;
#pragma unroll
            for (int w = 0; w < 8; ++w) s += scr[w * 128 + C.tid];
            ((float*)(C.ws + WS_KMEAN))[(h * 32 + c) * 128 + C.tid] = s * (1.0f / 256.0f); }
        PREP_BAR();
    }
}
__device__ __forceinline__ void prep_ssd_load(const Ctx& C, int u, v4u (&rawq)[7], float& dtraw) {
    const int c = u / 48, s = u % 48, ch0 = 64 * s; const bf16* MIX = (const bf16*)(C.ws + A_MIX); const int cg = C.tid & 7, rg = C.tid >> 3;
#pragma unroll
    for (int i = 0; i < 7; ++i) { const int t = 256 * c + 4 * rg - 3 + i; rawq[i] = t >= 0 ? *(const v4u*)(MIX + (size_t)t * NMIX + MC_XBC + ch0 + cg * 8) : (v4u){0u, 0u, 0u, 0u}; }
    dtraw = (s < 32 && C.tid < 256) ? bf2f(MIX[(size_t)(256 * c + C.tid) * NMIX + MC_DT + s]) : 0.f;
}
__device__ __forceinline__ void prep_ssd_unit(const Ctx& C, int l, int u, const v4u (&rawq)[7], float dtraw, bool hn, int un, v4u (&nq)[7], float& ndt) {
    const int c = u / 48, s = u % 48, ch0 = 64 * s;
    bf16* XC = (bf16*)(C.ws + A_XC);
    float* dtL = (float*)(C.lds); float* adL = dtL + 256;
    bf16* T = (bf16*)(C.lds + 4096);
    const int cg = C.tid & 7, rg = C.tid >> 3;
    const float* wc = C.in[IN_WSCONV] + (size_t)l * 4 * XBCW + ch0 + cg * 8; const float* bc = C.in[IN_BSCONV] + (size_t)l * XBCW + ch0 + cg * 8;
    float wv[4][8], bv[8];
#pragma unroll
    for (int j = 0; j < 4; ++j) { const f32x4 a = *(const f32x4*)(wc + j * XBCW), b = *(const f32x4*)(wc + j * XBCW + 4);
        wv[j][0] = a[0]; wv[j][1] = a[1]; wv[j][2] = a[2]; wv[j][3] = a[3]; wv[j][4] = b[0]; wv[j][5] = b[1]; wv[j][6] = b[2]; wv[j][7] = b[3]; }
    { const f32x4 a = *(const f32x4*)bc, b = *(const f32x4*)(bc + 4); bv[0] = a[0]; bv[1] = a[1]; bv[2] = a[2]; bv[3] = a[3]; bv[4] = b[0]; bv[5] = b[1]; bv[6] = b[2]; bv[7] = b[3]; }
    const float alog_ = C.in[IN_ALOG][l * 32 + (s & 31)], dtb_ = C.in[IN_DTB][l * 32 + (s & 31)];
    if (hn) prep_ssd_load(C, un, nq, ndt);
    if (s < 32) {
        if (C.tid < 256) { const float a = -__expf(alog_);
            const float raw = dtraw + dtb_;
            const float ex = __expf(raw); const float dt = raw > 20.f ? raw : (ex < 1e-3f ? ex * (1.0f - ex * (0.5f - ex * (1.0f / 3.0f))) : __logf(1.0f + ex));
            dtL[C.tid] = dt; adL[C.tid] = dt * a; }
        PREP_BAR();
        if (C.wave == 0) {
            float v0 = adL[4 * C.lane], v1 = adL[4 * C.lane + 1], v2 = adL[4 * C.lane + 2], v3 = adL[4 * C.lane + 3];
            v1 += v0; v2 += v1; v3 += v2; float tot = v3;
#pragma unroll
            for (int o = 1; o < 64; o <<= 1) { const float t = __shfl_up(tot, o); if (C.lane >= o) tot += t; }
            const float base = tot - v3;
            float* ac = (float*)(C.ws + WS_ACST) + (size_t)s * S_ + 256 * c + 4 * C.lane;
            *(f32x4*)ac = (f32x4){base + v0, base + v1, base + v2, base + v3}; }
    }
    float raw[7][8];
#pragma unroll
    for (int i = 0; i < 7; ++i) { UNPACK8(rawq[i], raw[i]); }
#pragma unroll
    for (int i = 0; i < 4; ++i) { float o[8]; const int rl = 4 * rg + i;
#pragma unroll
        for (int e = 0; e < 8; ++e) { float v = bv[e];
#pragma unroll
            for (int j = 0; j < 4; ++j) v += wv[j][e] * raw[i + j][e];
            o[e] = silu_f(v); }
        *(v4u*)(XC + (size_t)(256 * c + rl) * XBCW + ch0 + cg * 8) = PACK8(o);
        if (s < 40) { const float sc = s < 32 ? dtL[rl] : 1.0f;
#pragma unroll
            for (int e = 0; e < 8; ++e) T[(cg * 8 + e) * 264 + rl] = (bf16)f2bf(o[e] * sc); } }
    if (s < 40) {
        PREP_BAR();
        bf16* dstT = s < 32 ? (bf16*)(C.ws + A_XDT) + (size_t)(64 * s) * S_ : (bf16*)(C.ws + A_BT) + (size_t)(64 * (s - 32)) * S_;
        const int ch = C.tid >> 3;
#pragma unroll
        for (int jj = 0; jj < 4; ++jj) { const int chunk = (C.tid & 7) + 8 * jj;
            const v4u w = *(const v4u*)(T + ch * 264 + chunk * 8);
            *(v4u*)(dstT + (size_t)ch * S_ + 256 * c + chunk * 8) = w; }
    }
    PREP_BAR();
}
__device__ __forceinline__ void prep_conv_load(const Ctx& C, int u, v4u (&aq)[6], v4u (&bq)[6], v4u (&gq)[4]) {
    const int c = u >> 4, s = u & 15, ch0 = 64 * s, cg = C.tid & 7, rg = C.tid >> 3; const bf16* MIX = (const bf16*)(C.ws + A_MIX);
#pragma unroll
    for (int i = 0; i < 6; ++i) { const int t = 256 * c + 4 * rg - 2 + i;
        aq[i] = t >= 0 ? *(const v4u*)(MIX + (size_t)t * NMIX + MC_CC + ch0 + cg * 8) : (v4u){0u, 0u, 0u, 0u}; bq[i] = t >= 0 ? *(const v4u*)(MIX + (size_t)t * NMIX + MC_CX + ch0 + cg * 8) : (v4u){0u, 0u, 0u, 0u}; }
#pragma unroll
    for (int i = 0; i < 4; ++i) gq[i] = *(const v4u*)(MIX + (size_t)(256 * c + 4 * rg + i) * NMIX + MC_CB + ch0 + cg * 8);
}
__device__ __forceinline__ void prep_conv_unit(const Ctx& C, int l, int u, const v4u (&aq)[6], const v4u (&bq)[6], const v4u (&gq)[4]) {
    const int c = u >> 4, s = u & 15, ch0 = 64 * s, cg = C.tid & 7, rg = C.tid >> 3;
    bf16* Y = (bf16*)(C.ws + A_YCAT) + YC_CONV;
    const float* wc = C.in[IN_WSC] + (size_t)l * 3 * CWID + ch0 + cg * 8;
    float wv[3][8];
#pragma unroll
    for (int j = 0; j < 3; ++j) { const f32x4 a = *(const f32x4*)(wc + j * CWID), b = *(const f32x4*)(wc + j * CWID + 4);
        wv[j][0] = a[0]; wv[j][1] = a[1]; wv[j][2] = a[2]; wv[j][3] = a[3]; wv[j][4] = b[0]; wv[j][5] = b[1]; wv[j][6] = b[2]; wv[j][7] = b[3]; }
    float pr[6][8];
#pragma unroll
    for (int i = 0; i < 6; ++i) { float fa[8], fb[8]; UNPACK8(aq[i], fa); UNPACK8(bq[i], fb);
#pragma unroll
        for (int e = 0; e < 8; ++e) pr[i][e] = fa[e] * fb[e]; }
#pragma unroll
    for (int i = 0; i < 4; ++i) { const int t = 256 * c + 4 * rg + i;
        const v4u g = gq[i]; float fg[8], o[8]; UNPACK8(g, fg);
#pragma unroll
        for (int e = 0; e < 8; ++e) o[e] = fg[e] * (wv[0][e] * pr[i][e] + wv[1][e] * pr[i + 1][e] + wv[2][e] * pr[i + 2][e]);
        *(v4u*)(Y + (size_t)t * YCAT_LD + ch0 + cg * 8) = PACK8(o); }
}
__device__ __forceinline__ void ph_prep_qk(const Ctx& C, int l) {
    int u = C.bid; v4u cur[8], nxt[8];
    if (u < 512) prep_qk_load(C, u, cur);
    for (; u < 512; u += C.G) { const bool hn = u + C.G < 512; prep_qk_unit(C, l, u, cur, hn, u + C.G, nxt);
        if (hn) {
#pragma unroll
            for (int i = 0; i < 8; ++i) cur[i] = nxt[i]; } }
}
__device__ __forceinline__ void ph_prep_ssd(const Ctx& C, int l) {
    int u = (512 / C.G) * C.G + C.bid; if (u < 512) u += C.G; u -= 512;
    v4u cur[7], nxt[7]; float cdt = 0.f, ndt = 0.f;
    if (u < 1536) prep_ssd_load(C, u, cur, cdt);
    for (; u < 1536; u += C.G) { const bool hn = u + C.G < 1536; prep_ssd_unit(C, l, u, cur, cdt, hn, u + C.G, nxt, ndt);
        if (hn) { cdt = ndt;
#pragma unroll
            for (int i = 0; i < 7; ++i) cur[i] = nxt[i]; } }
}
__device__ __forceinline__ void ph_prep_conv(const Ctx& C, int l) {
    int u = (2048 / C.G) * C.G + C.bid; if (u < 2048) u += C.G; u -= 2048;
    for (; u < 512; u += C.G) { v4u ca[6], cb[6], cg[4]; prep_conv_load(C, u, ca, cb, cg); prep_conv_unit(C, l, u, ca, cb, cg); }
}

#define MFMA32(a, b, c) __builtin_amdgcn_mfma_f32_32x32x16_bf16(__builtin_bit_cast(bf16x8, a), __builtin_bit_cast(bf16x8, b), c, 0, 0, 0)
#define TK_BETTER(v, j, bv, bj) ((v) > (bv) || ((v) == (bv) && (j) < (bj)))
#define TK_INSERT(v, j) do { if (TK_BETTER(v, j, b0, j0)) { b2 = b1; j2 = j1; b1 = b0; j1 = j0; b0 = (v); j0 = (j); } \
                             else if (TK_BETTER(v, j, b1, j1)) { b2 = b1; j2 = j1; b1 = (v); j1 = (j); } \
                             else if (TK_BETTER(v, j, b2, j2)) { b2 = (v); j2 = (j); } } while (0)
__device__ __forceinline__ void select_unit(const Ctx& C, int l, int u) {
    const int h = u >> 5, qb = u & 31;
    if (qb == 0) return;
    const int r32 = C.lane & 31, hi = C.lane >> 5, q = 256 * qb + 32 * C.wave + r32;
    LAS unsigned* hist = (LAS unsigned*)((LAS unsigned char*)C.lds); LAS unsigned* basev = hist + 32;
    if (C.tid < 32) hist[C.tid] = 0u;
    const bf16* qp = (const bf16*)(C.ws + A_QN) + (size_t)q * AW + h * 128 + 8 * hi;
    const float* kp = (const float*)(C.ws + WS_KMEAN) + ((size_t)h * 32 + r32) * 128 + 8 * hi;
    f32x16 acc = {};
    v4u qv[8]; f32x4 kv0[8], kv1[8];
#pragma unroll
    for (int ks = 0; ks < 8; ++ks) { qv[ks] = *(const v4u*)(qp + 16 * ks); kv0[ks] = *(const f32x4*)(kp + 16 * ks); kv1[ks] = *(const f32x4*)(kp + 16 * ks + 4); }
#pragma unroll
    for (int ks = 0; ks < 8; ++ks) { const v4u b = qv[ks];
        const f32x4 k0 = kv0[ks], k1 = kv1[ks];
        float kh[8], kl[8];
        kh[0] = __uint_as_float(f2bf(k0[0]) << 16); kh[1] = __uint_as_float(f2bf(k0[1]) << 16); kh[2] = __uint_as_float(f2bf(k0[2]) << 16); kh[3] = __uint_as_float(f2bf(k0[3]) << 16);
        kh[4] = __uint_as_float(f2bf(k1[0]) << 16); kh[5] = __uint_as_float(f2bf(k1[1]) << 16); kh[6] = __uint_as_float(f2bf(k1[2]) << 16); kh[7] = __uint_as_float(f2bf(k1[3]) << 16);
        kl[0] = k0[0] - kh[0]; kl[1] = k0[1] - kh[1]; kl[2] = k0[2] - kh[2]; kl[3] = k0[3] - kh[3]; kl[4] = k1[0] - kh[4]; kl[5] = k1[1] - kh[5]; kl[6] = k1[2] - kh[6]; kl[7] = k1[3] - kh[7];
        const v4u ah = PACK8(kh), al = PACK8(kl);
        acc = MFMA32(ah, b, acc); acc = MFMA32(al, b, acc); }
    int j0 = 64, j1 = 64, j2 = 64; float b0 = -INFINITY, b1 = -INFINITY, b2 = -INFINITY;
#pragma unroll
    for (int r = 0; r < 16; ++r) { const int j = crow(r, hi); if (j < qb) { const float v = acc[r]; TK_INSERT(v, j); } }
    { const auto s0_ = __builtin_amdgcn_permlane32_swap(__float_as_uint(b0), __float_as_uint(b0), false, false); const auto t0_ = __builtin_amdgcn_permlane32_swap((unsigned)j0, (unsigned)j0, false, false);
      const auto s1_ = __builtin_amdgcn_permlane32_swap(__float_as_uint(b1), __float_as_uint(b1), false, false); const auto t1_ = __builtin_amdgcn_permlane32_swap((unsigned)j1, (unsigned)j1, false, false);
      const auto s2_ = __builtin_amdgcn_permlane32_swap(__float_as_uint(b2), __float_as_uint(b2), false, false); const auto t2_ = __builtin_amdgcn_permlane32_swap((unsigned)j2, (unsigned)j2, false, false);
      const float o0 = __uint_as_float(hi ? s0_[0] : s0_[1]), o1 = __uint_as_float(hi ? s1_[0] : s1_[1]), o2 = __uint_as_float(hi ? s2_[0] : s2_[1]);
      const int p0 = (int)(hi ? t0_[0] : t0_[1]), p1 = (int)(hi ? t1_[0] : t1_[1]), p2 = (int)(hi ? t2_[0] : t2_[1]);
      if (p0 < 64) TK_INSERT(o0, p0); if (p1 < 64) TK_INSERT(o1, p1); if (p2 < 64) TK_INSERT(o2, p2); }
    __syncthreads();
    unsigned* cnt = (unsigned*)(C.ws + WS_CNT) + (size_t)(l * 8 + h) * 32 * CNT_STRIDE; unsigned* list = (unsigned*)(C.ws + WS_LIST) + (size_t)h * 32 * S_;
    unsigned r0 = 0u, r1 = 0u, r2 = 0u;
    if (hi == 0) {
        if (j0 < 64) r0 = __hip_atomic_fetch_add(hist + j0, 1u, __ATOMIC_RELAXED, __HIP_MEMORY_SCOPE_WORKGROUP);
        if (j1 < 64) r1 = __hip_atomic_fetch_add(hist + j1, 1u, __ATOMIC_RELAXED, __HIP_MEMORY_SCOPE_WORKGROUP);
        if (j2 < 64) r2 = __hip_atomic_fetch_add(hist + j2, 1u, __ATOMIC_RELAXED, __HIP_MEMORY_SCOPE_WORKGROUP); }
    __syncthreads();
    if (C.tid < qb) { const unsigned c = hist[C.tid]; basev[C.tid] = c ? atomicAdd(cnt + C.tid * CNT_STRIDE, c) : 0u; }
    __syncthreads();
    if (hi == 0) {
        if (j0 < 64) list[(size_t)j0 * S_ + basev[j0] + r0] = (unsigned)q | (1u << 16);
        if (j1 < 64) list[(size_t)j1 * S_ + basev[j1] + r1] = (unsigned)q | (2u << 16);
        if (j2 < 64) list[(size_t)j2 * S_ + basev[j2] + r2] = (unsigned)q | (3u << 16); }
    __syncthreads();
}
#undef TK_INSERT
#undef TK_BETTER
__device__ __forceinline__ void ssd_state_unit(const Ctx& C, int u) {
    const int c = u >> 5, hh = u & 31, g = hh >> 3, mi = C.wave >> 2, ni = C.wave & 3, r32 = C.lane & 31, hi = C.lane >> 5;
    const bf16* Ap = (const bf16*)(C.ws + A_XDT) + (size_t)(64 * hh + 32 * mi + r32) * S_ + 256 * c + 8 * hi;
    const bf16* Bp = (const bf16*)(C.ws + A_BT) + (size_t)(128 * g + 32 * ni + r32) * S_ + 256 * c + 8 * hi;
    const float* ac = (const float*)(C.ws + WS_ACST) + (size_t)hh * S_ + 256 * c;
    float* dte = (float*)(C.lds + C.wave * 1024);
    const f32x4 dv = *(const f32x4*)(ac + 4 * C.lane); const float aend = ac[255];
    v4u av[16], bv[16];
#pragma unroll
    for (int ks = 0; ks < 16; ++ks) { av[ks] = *(const v4u*)(Ap + 16 * ks); bv[ks] = *(const v4u*)(Bp + 16 * ks); }
    *(f32x4*)(dte + 4 * C.lane) = (f32x4){__expf(aend - dv[0]), __expf(aend - dv[1]), __expf(aend - dv[2]), __expf(aend - dv[3])};
    asm volatile("s_waitcnt lgkmcnt(0)" ::: "memory");
    f32x16 acc = {};
#pragma unroll
    for (int ks = 0; ks < 16; ++ks) { const f32x4 d0 = *(const f32x4*)(dte + 16 * ks + 8 * hi), d1 = *(const f32x4*)(dte + 16 * ks + 8 * hi + 4);
        float f[8]; UNPACK8(av[ks], f);
        f[0] *= d0[0]; f[1] *= d0[1]; f[2] *= d0[2]; f[3] *= d0[3]; f[4] *= d1[0]; f[5] *= d1[1]; f[6] *= d1[2]; f[7] *= d1[3];
        const v4u a2 = PACK8(f);
        acc = MFMA32(a2, bv[ks], acc); }
    asm volatile("s_waitcnt lgkmcnt(0)" ::: "memory");
    float* st = (float*)(C.ws + A_STATES) + ((size_t)(c * 32 + hh) * 64 + 32 * mi) * 128 + 32 * ni + r32;
#pragma unroll
    for (int r = 0; r < 16; ++r) st[(size_t)crow(r, hi) * 128] = acc[r];
}
__device__ __forceinline__ void ssd_cb_unit(const Ctx& C, int u) {
    const int c = u >> 2, g = u & 3, r32 = C.lane & 31, hi = C.lane >> 5;
    const bf16* XC = (const bf16*)(C.ws + A_XC); bf16* CB = (bf16*)(C.ws + A_CBM) + (size_t)(c * 4 + g) * 65536;
    for (int tt = C.wave; tt < 36; tt += NWAVES) { int li = 0; while ((li + 1) * (li + 2) / 2 <= tt) ++li; const int si = tt - li * (li + 1) / 2;
        const bf16* Ap = XC + (size_t)(256 * c + 32 * li + r32) * XBCW + 2560 + 128 * g + 8 * hi;
        const bf16* Bp = XC + (size_t)(256 * c + 32 * si + r32) * XBCW + 2048 + 128 * g + 8 * hi;
        f32x16 acc = {};
        v4u av[8], bv[8];
#pragma unroll
        for (int ks = 0; ks < 8; ++ks) { av[ks] = *(const v4u*)(Ap + 16 * ks); bv[ks] = *(const v4u*)(Bp + 16 * ks); }
#pragma unroll
        for (int ks = 0; ks < 8; ++ks) acc = MFMA32(av[ks], bv[ks], acc);
        bf16* o = CB + (size_t)(32 * li) * 256 + 32 * si + r32;
#pragma unroll
        for (int r = 0; r < 16; ++r) o[(size_t)crow(r, hi) * 256] = (bf16)f2bf(acc[r]); }
}
__device__ __forceinline__ void ph_select(const Ctx& C, int l) {
#ifndef REP_STATE
#define REP_STATE 1
#endif
#ifndef REP_CB
#define REP_CB 1
#endif
    for (int u = C.bid; u < 256; u += C.G) select_unit(C, l, u);
    for (int rr = 0; rr < REP_STATE; ++rr) for (int u = C.bid; u < 1024; u += C.G) ssd_state_unit(C, u);
    for (int rr = 0; rr < REP_CB; ++rr) for (int u = C.bid; u < 128; u += C.G) ssd_cb_unit(C, u);
}

__device__ __forceinline__ void ssd_recur(const Ctx& C) {
    const float* ST = (const float*)(C.ws + A_STATES); bf16* PV = (bf16*)(C.ws + A_PREV); const float* ACS = (const float*)(C.ws + WS_ACST);
    for (int e2 = C.bid * (NWAVES * 64) + C.tid; e2 < 32 * 64 * 64; e2 += C.G * NWAVES * 64) {
        const int hh = e2 >> 12, rem = e2 & 4095, p = rem >> 6, n = (rem & 63) * 2;
        f32x2 st[NCH]; float dc[NCH];
#pragma unroll
        for (int c = 0; c < NCH; ++c) { st[c] = *(const f32x2*)(ST + ((size_t)(c * 32 + hh) * 64 + p) * 128 + n); dc[c] = ACS[(size_t)hh * S_ + 256 * c + 255]; }
        float p0 = 0.f, p1 = 0.f;
#pragma unroll
        for (int c = 0; c < NCH; ++c) { const size_t off = ((size_t)(c * 32 + hh) * 64 + p) * 128 + n;
            *(unsigned*)(PV + off) = pk2(p0, p1);
            const float dec = __expf(dc[c]); p0 = dec * p0 + st[c].x; p1 = dec * p1 + st[c].y; }
    }
}
constexpr int SHM_T = 64 * 128 * 2;
#define KSWZ(row, colB) ((row) * 256 + ((colB) ^ (((row) & 7) << 4)))
__device__ __forceinline__ int v_st(int k, int c) { const int kk = (k & ~0xC) | ((k & 4) << 1) | ((k & 8) >> 1); return ((kk >> 3) * 4 + (c >> 5)) * 512 + ((kk & 7) * 32 + (c & 31)) * 2; }
__device__ __forceinline__ int v_rd_base(int lane) { return ((lane & 3) << 3) | (((lane >> 2) & 3) << 6) | (((lane >> 4) & 1) << 5) | (((lane >> 5) & 1) << 8); }
constexpr int v_rd_off(int d0, int ks, int half) { return d0 * 512 + ks * 4096 + half * 2048; }
template <int KB>
__device__ __forceinline__ void qkt(f32x16& p0, f32x16& p1, const char* K_lds, int r32, int hi, const bf16x8* qr, float cinit) {
#pragma unroll
    for (int r = 0; r < 16; ++r) { p0[r] = cinit; p1[r] = cinit; }
    const char* kb[4];
#pragma unroll
    for (int dd = 0; dd < 4; ++dd) kb[dd] = K_lds + KB * SHM_T + KSWZ(r32, (dd * 16 + hi * 8) * 2);
#pragma unroll
    for (int d0 = 0; d0 < 8; ++d0) { const char* a = kb[d0 & 3] + (d0 >> 2) * 128;
        const bf16x8 b0 = *reinterpret_cast<const bf16x8*>(a);
        const bf16x8 b1 = *reinterpret_cast<const bf16x8*>(a + 32 * 256);
        p0 = __builtin_amdgcn_mfma_f32_32x32x16_bf16(b0, qr[d0], p0, 0, 0, 0);
        p1 = __builtin_amdgcn_mfma_f32_32x32x16_bf16(b1, qr[d0], p1, 0, 0, 0); }
}
template <int VB>
__device__ __forceinline__ void pv_tile(f32x16* o, int vb0, bf16x8 pa0, bf16x8 pa1, bf16x8 pa2, bf16x8 pa3) {
#define TRRD(dst, off) asm volatile("ds_read_b64_tr_b16 %0, %1 offset:%2" : "=&v"(dst) : "v"(vb0), "i"(off) : "memory")
#define PV_D0(d0) do { s16x4 l0, l1, l2, l3, h0, h1, h2, h3; constexpr int b_ = VB * SHM_T + v_rd_off(d0, 0, 0); \
        TRRD(l0, b_); TRRD(h0, b_ + 2048); TRRD(l1, b_ + 4096); TRRD(h1, b_ + 6144); TRRD(l2, b_ + 8192); TRRD(h2, b_ + 10240); TRRD(l3, b_ + 12288); TRRD(h3, b_ + 14336); \
        asm volatile("s_waitcnt lgkmcnt(0)" ::: "memory"); __builtin_amdgcn_sched_barrier(0); \
        o[d0] = __builtin_amdgcn_mfma_f32_32x32x16_bf16(pa0, (bf16x8){l0[0], l0[1], l0[2], l0[3], h0[0], h0[1], h0[2], h0[3]}, o[d0], 0, 0, 0); \
        o[d0] = __builtin_amdgcn_mfma_f32_32x32x16_bf16(pa1, (bf16x8){l1[0], l1[1], l1[2], l1[3], h1[0], h1[1], h1[2], h1[3]}, o[d0], 0, 0, 0); \
        o[d0] = __builtin_amdgcn_mfma_f32_32x32x16_bf16(pa2, (bf16x8){l2[0], l2[1], l2[2], l2[3], h2[0], h2[1], h2[2], h2[3]}, o[d0], 0, 0, 0); \
        o[d0] = __builtin_amdgcn_mfma_f32_32x32x16_bf16(pa3, (bf16x8){l3[0], l3[1], l3[2], l3[3], h3[0], h3[1], h3[2], h3[3]}, o[d0], 0, 0, 0); } while (0)
    PV_D0(0); PV_D0(1); PV_D0(2); PV_D0(3);
#undef PV_D0
#undef TRRD
}
__device__ __forceinline__ void sm_step(f32x16& p0, f32x16& p1, float& m_reg, float& l_reg, f32x16* o, float* al_l, int r32, int hi, bf16x8& pa0, bf16x8& pa1, bf16x8& pa2, bf16x8& pa3) {
    float pmax = p0[0];
#pragma unroll
    for (int r = 1; r < 16; ++r) pmax = fmaxf(pmax, p0[r]);
#pragma unroll
    for (int r = 0; r < 16; ++r) pmax = fmaxf(pmax, p1[r]);
    { auto rr = __builtin_amdgcn_permlane32_swap(__float_as_uint(pmax), __float_as_uint(pmax), false, false); pmax = fmaxf(__uint_as_float(rr[0]), __uint_as_float(rr[1])); }
    const float mn = (pmax - m_reg <= 8.0f) ? m_reg : fmaxf(m_reg, pmax); const float alpha = __builtin_amdgcn_exp2f(m_reg - mn); m_reg = mn;
    float ps = 0.f;
#pragma unroll
    for (int r = 0; r < 16; ++r) { p0[r] = __builtin_amdgcn_exp2f(p0[r] - mn); ps += p0[r]; }
#pragma unroll
    for (int r = 0; r < 16; ++r) { p1[r] = __builtin_amdgcn_exp2f(p1[r] - mn); ps += p1[r]; }
    { auto rr = __builtin_amdgcn_permlane32_swap(__float_as_uint(ps), __float_as_uint(ps), false, false); ps = __uint_as_float(rr[0]) + __uint_as_float(rr[1]); }
    l_reg = l_reg * alpha + ps;
    if (__any(alpha < 1.f)) { if (hi == 0) al_l[r32] = alpha; asm volatile("s_waitcnt lgkmcnt(0)" ::: "memory");
#pragma unroll
        for (int d_ = 0; d_ < 4; ++d_)
#pragma unroll
            for (int r = 0; r < 16; ++r) o[d_][r] *= al_l[crow(r, hi)]; }
#define PK4(P, B_, OUT) do { unsigned a0 = cvtpk(P[B_ + 0], P[B_ + 1]), a1 = cvtpk(P[B_ + 2], P[B_ + 3]); unsigned b0 = cvtpk(P[B_ + 4], P[B_ + 5]), b1 = cvtpk(P[B_ + 6], P[B_ + 7]); \
        auto r0 = __builtin_amdgcn_permlane32_swap(a0, b0, false, false); auto r1 = __builtin_amdgcn_permlane32_swap(a1, b1, false, false); \
        v4u w = {r0[0], r1[0], r0[1], r1[1]}; OUT = __builtin_bit_cast(bf16x8, w); } while (0)
    PK4(p0, 0, pa0); PK4(p0, 8, pa1); PK4(p1, 0, pa2); PK4(p1, 8, pa3);
#undef PK4
}
__device__ __forceinline__ void attn_item(const Ctx& C, int h, int j, bool own, int k, int cnt, bool stage, int pmode) {
    const int tid = C.tid, wid = C.wave, lane = C.lane, r32 = lane & 31, hi = lane >> 5;
    char* V_lds = (char*)C.lds; char* K_lds = (char*)C.lds + 4 * SHM_T;
    float* wsf = (float*)(C.lds + SCR_OFF) + wid * 64; float* li_l = wsf; float* al_l = wsf + 32;
    int* qtab = (int*)(C.lds + SCR_OFF + 2048) + wid * 32; float* lut = (float*)(C.lds + SCR_OFF + 3072);
    bf16* ostg = (bf16*)(C.lds + SCR_OFF + 8192) + wid * 1024;
    const bf16* KN = (const bf16*)(C.ws + A_KN); const bf16* QN = (const bf16*)(C.ws + A_QN); const bf16* MIX = (const bf16*)(C.ws + A_MIX);
    int q, slot; bool valid; unsigned ent = 0u;
    if (own) { q = 256 * j + 32 * wid + r32; slot = 0; valid = true; }
    else { const int e = 256 * k + 32 * wid + r32; valid = e < cnt; ent = ((const unsigned*)(C.ws + WS_LIST))[((size_t)h * 32 + j) * S_ + (valid ? e : 0)]; q = 0; slot = 0; }
    const int sr = tid >> 4, sc = (tid & 15) * 8; const int kws = KSWZ(sr, sc * 2), vst0 = v_st(sr, sc), vst1 = v_st(32 + sr, sc);
    v4u kr[4][2], vr[4][2];
    if (pmode == 2) stage = false;
    if (stage) {
        __syncthreads();
#pragma unroll
        for (int t = 0; t < 4; ++t) { const size_t row = (size_t)(256 * j + 64 * t + sr);
            kr[t][0] = *(const v4u*)(KN + row * AW + h * 128 + sc); kr[t][1] = *(const v4u*)(KN + (row + 32) * AW + h * 128 + sc); }
#pragma unroll
        for (int t = 0; t < 4; ++t) { const size_t row = (size_t)(256 * j + 64 * t + sr);
            vr[t][0] = *(const v4u*)(MIX + row * NMIX + MC_V + h * 128 + sc); vr[t][1] = *(const v4u*)(MIX + (row + 32) * NMIX + MC_V + h * 128 + sc); }
    }
    if (!own) { q = (int)(ent & 0xffffu); slot = (int)(ent >> 16); }
    bf16x8 qr[8];
#pragma unroll
    for (int d0 = 0; d0 < 8; ++d0) qr[d0] = *reinterpret_cast<const bf16x8*>(QN + (size_t)q * AW + h * 128 + d0 * 16 + hi * 8);
    if (stage) {
#pragma unroll
        for (int t = 0; t < 4; ++t) { *(v4u*)(K_lds + t * SHM_T + kws) = kr[t][0]; *(v4u*)(K_lds + t * SHM_T + kws + 32 * 256) = kr[t][1];
            *(v4u*)(V_lds + t * SHM_T + vst0) = vr[t][0]; *(v4u*)(V_lds + t * SHM_T + vst1) = vr[t][1]; }
        if (tid < 129) lut[tid] = ((const float*)(C.ws + WS_LUT))[h * 132 + tid];
        __syncthreads();
    }
    if (!own && 256 * k + 32 * wid >= cnt) return;
    if (hi == 0) qtab[r32] = valid ? (q | (slot << 16)) : -1;
    float m_reg = -1e30f, l_reg = 0.f; f32x16 o[4] = {};
    const int vb0 = (int)(uintptr_t)V_lds + v_rd_base(lane);
    const float far = lut[128];
    const bool near = own || __any(valid && (q - (256 * j + 255) < 128));
    f32x16 pA0, pA1, pB0, pB1; bf16x8 pa0, pa1, pa2, pa3;
    const int ntile = own ? ((32 * wid + 31) / 64 + 1) : 4;
#define ATT_MB(t, P0, P1) do { \
        if (near) { const int dq = q - (256 * j + 64 * (t)) - 4 * hi; float b0_[16], b1_[16]; \
            _Pragma("unroll") for (int r = 0; r < 16; ++r) { const int cc = (r & 3) + 8 * (r >> 2); const int d0_ = dq - cc, d1_ = d0_ - 32; \
                b0_[r] = lut[d0_ < 0 ? 0 : (d0_ < 128 ? d0_ : 128)]; b1_[r] = lut[d1_ < 0 ? 0 : (d1_ < 128 ? d1_ : 128)]; } \
            _Pragma("unroll") for (int r = 0; r < 16; ++r) { const int cc = (r & 3) + 8 * (r >> 2); const int d0_ = dq - cc, d1_ = d0_ - 32; \
                P0[r] = d0_ < 0 ? -INFINITY : P0[r] + b0_[r]; P1[r] = d1_ < 0 ? -INFINITY : P1[r] + b1_[r]; } } \
        else { _Pragma("unroll") for (int r = 0; r < 16; ++r) { P0[r] += far; P1[r] += far; } } } while (0)
#define ATT_SB() __builtin_amdgcn_sched_barrier(0)
    if (pmode != 1) {
        if (pmode != 5) qkt<0>(pA0, pA1, K_lds, r32, hi, qr, 0.f); ATT_SB();
        if (ntile > 1) { if (pmode != 5) qkt<1>(pB0, pB1, K_lds, r32, hi, qr, 0.f); ATT_SB(); }
        ATT_MB(0, pA0, pA1); if (pmode != 4) sm_step(pA0, pA1, m_reg, l_reg, o, al_l, r32, hi, pa0, pa1, pa2, pa3); ATT_SB(); if (pmode != 3) pv_tile<0>(o, vb0, pa0, pa1, pa2, pa3); ATT_SB();
        if (ntile > 1) {
            if (ntile > 2) { if (pmode != 5) qkt<2>(pA0, pA1, K_lds, r32, hi, qr, 0.f); ATT_SB(); }
            ATT_MB(1, pB0, pB1); if (pmode != 4) sm_step(pB0, pB1, m_reg, l_reg, o, al_l, r32, hi, pa0, pa1, pa2, pa3); ATT_SB(); if (pmode != 3) pv_tile<1>(o, vb0, pa0, pa1, pa2, pa3); ATT_SB();
            if (ntile > 2) {
                if (ntile > 3) { if (pmode != 5) qkt<3>(pB0, pB1, K_lds, r32, hi, qr, 0.f); ATT_SB(); }
                ATT_MB(2, pA0, pA1); if (pmode != 4) sm_step(pA0, pA1, m_reg, l_reg, o, al_l, r32, hi, pa0, pa1, pa2, pa3); ATT_SB(); if (pmode != 3) pv_tile<2>(o, vb0, pa0, pa1, pa2, pa3); ATT_SB();
                if (ntile > 3) { ATT_MB(3, pB0, pB1); if (pmode != 4) sm_step(pB0, pB1, m_reg, l_reg, o, al_l, r32, hi, pa0, pa1, pa2, pa3); ATT_SB(); if (pmode != 3) pv_tile<3>(o, vb0, pa0, pa1, pa2, pa3); } } }
    }
#undef ATT_MB
#undef ATT_SB
    if (hi == 0) li_l[r32] = l_reg; asm volatile("s_waitcnt lgkmcnt(0)" ::: "memory");
    float rl[16];
#pragma unroll
    for (int r = 0; r < 16; ++r) rl[r] = __builtin_amdgcn_rcpf(li_l[crow(r, hi)]);
    bf16* PART = (bf16*)(C.ws + A_PART);
#pragma unroll
    for (int d0 = 0; d0 < 4; ++d0) {
#pragma unroll
        for (int r = 0; r < 16; ++r) ostg[crow(r, hi) * 32 + r32] = (bf16)f2bf(o[d0][r] * rl[r]);
        asm volatile("s_waitcnt lgkmcnt(0)" ::: "memory");
#pragma unroll
        for (int i = 0; i < 2; ++i) { const int id = lane + 64 * i, row = id >> 2, ch = id & 3; const int en = qtab[row];
            const v4u w = *(const v4u*)(ostg + row * 32 + ch * 8);
            if (en >= 0) *(v4u*)(PART + ((size_t)((en >> 16) & 3) * S_ + (size_t)(en & 0xffff)) * AW + h * 128 + d0 * 32 + ch * 8) = w; }
        asm volatile("s_waitcnt lgkmcnt(0)" ::: "memory"); }
    if (hi == 0 && valid) { float* ml = (float*)(C.ws + WS_ML) + (((size_t)slot * S_ + q) * 8 + h) * 2; *(f32x2*)ml = (f32x2){m_reg, l_reg}; }
}
__device__ __forceinline__ void ph_attn(const Ctx& C, int l, int pmode) {
#ifndef REP_RECUR
#define REP_RECUR 1
#endif
    for (int rr = 0; rr < REP_RECUR; ++rr) ssd_recur(C);
    int* cntL = (int*)(C.lds + SCR_OFF + 4096); int* pre = cntL + 256;
    if (C.tid < 256) { const int n = (int)__hip_atomic_load((const unsigned*)(C.ws + WS_CNT) + (size_t)(l * 256 + C.tid) * CNT_STRIDE, __ATOMIC_RELAXED, __HIP_MEMORY_SCOPE_AGENT); cntL[C.tid] = n; }
    __syncthreads();
    if (C.wave == 0) { int v[4], tot = 0;
#pragma unroll
        for (int e = 0; e < 4; ++e) { v[e] = (cntL[4 * C.lane + e] + 255) >> 8; tot += v[e]; }
        int inc = tot;
#pragma unroll
        for (int o = 1; o < 64; o <<= 1) { const int t = __shfl_up(inc, o); if (C.lane >= o) inc += t; }
        int run = inc - tot;
#pragma unroll
        for (int e = 0; e < 4; ++e) { pre[4 * C.lane + e] = run; run += v[e]; }
        if (C.lane == 63) pre[256] = run; }
    __syncthreads();
    const int T = 256 + pre[256];
    const int t0 = (int)(((long)C.bid * T) / C.G), t1 = (int)(((long)(C.bid + 1) * T) / C.G);
    int last_hj = -1;
    for (int t = t0; t < t1; ++t) {
        if (t < 256) { attn_item(C, t >> 5, t & 31, true, 0, 256, last_hj != t, pmode); last_hj = t; continue; }
        const int tt = t - 256; int lo = 0, hi = 256;
        while (hi - lo > 1) { const int mid = (lo + hi) >> 1; if (pre[mid] <= tt) lo = mid; else hi = mid; }
        const int hj = __builtin_amdgcn_readfirstlane(lo), k = tt - __builtin_amdgcn_readfirstlane(pre[lo]), n = __builtin_amdgcn_readfirstlane(cntL[lo]);
        attn_item(C, hj >> 5, hj & 31, false, k, n, last_hj != hj, pmode); last_hj = hj;
    }
    __syncthreads();
}

__device__ __forceinline__ void ssd_tile(const Ctx& C, int l, int c, int hh, int w, bf16* slot, float* ssq_row) {
    const int g = hh >> 3, r32 = C.lane & 31, hi = C.lane >> 5;
    const float* ac = (const float*)(C.ws + WS_ACST) + (size_t)hh * S_ + 256 * c;
    float* acl = (float*)(C.lds + SCR_OFF + 8192) + C.wave * 256;
    const int lrow = 32 * w + r32; const float al = ac[lrow];
    *(f32x4*)(acl + 4 * C.lane) = *(const f32x4*)(ac + 4 * C.lane);
    asm volatile("s_waitcnt lgkmcnt(0)" ::: "memory");
    f32x16 acc0 = {}, acc1 = {};
    const bf16* Ap = (const bf16*)(C.ws + A_CBM) + ((size_t)(c * 4 + g) * 256 + lrow) * 256 + 8 * hi;
    const bf16* Bp0 = (const bf16*)(C.ws + A_XDT) + (size_t)(64 * hh + r32) * S_ + 256 * c + 8 * hi; const bf16* Bp1 = Bp0 + (size_t)32 * S_;
    const int nks = 2 * w + 2;
    for (int kb = 0; kb < nks; kb += 8) { const int nb = nks - kb < 8 ? nks - kb : 8;
        v4u av[8], b0v[8], b1v[8];
#pragma unroll
        for (int i = 0; i < 8; ++i) if (i < nb) { av[i] = *(const v4u*)(Ap + 16 * (kb + i)); b0v[i] = *(const v4u*)(Bp0 + 16 * (kb + i)); b1v[i] = *(const v4u*)(Bp1 + 16 * (kb + i)); }
#pragma unroll
        for (int i = 0; i < 8; ++i) if (i < nb) { const int s0 = 16 * (kb + i) + 8 * hi; const f32x4 d0 = *(const f32x4*)(acl + s0), d1 = *(const f32x4*)(acl + s0 + 4);
            float f[8]; UNPACK8(av[i], f);
            f[0] = (s0 + 0 <= lrow) ? f[0] * __expf(al - d0[0]) : 0.f; f[1] = (s0 + 1 <= lrow) ? f[1] * __expf(al - d0[1]) : 0.f;
            f[2] = (s0 + 2 <= lrow) ? f[2] * __expf(al - d0[2]) : 0.f; f[3] = (s0 + 3 <= lrow) ? f[3] * __expf(al - d0[3]) : 0.f;
            f[4] = (s0 + 4 <= lrow) ? f[4] * __expf(al - d1[0]) : 0.f; f[5] = (s0 + 5 <= lrow) ? f[5] * __expf(al - d1[1]) : 0.f;
            f[6] = (s0 + 6 <= lrow) ? f[6] * __expf(al - d1[2]) : 0.f; f[7] = (s0 + 7 <= lrow) ? f[7] * __expf(al - d1[3]) : 0.f;
            const v4u a2 = PACK8(f);
            acc0 = MFMA32(a2, b0v[i], acc0); acc1 = MFMA32(a2, b1v[i], acc1); } }
    v4u xt[4], zt[4];
#pragma unroll
    for (int i = 0; i < 4; ++i) { const int id = C.lane + 64 * i, row = id >> 3, ch = id & 7; const size_t grow = (size_t)(256 * c + 32 * w + row);
        xt[i] = *(const v4u*)((const bf16*)(C.ws + A_XC) + grow * XBCW + 64 * hh + ch * 8); zt[i] = *(const v4u*)((const bf16*)(C.ws + A_MIX) + grow * NMIX + MC_Z + 64 * hh + ch * 8); }
    { const float ea = __expf(al);
      const bf16* Cp = (const bf16*)(C.ws + A_XC) + (size_t)(256 * c + lrow) * XBCW + 2560 + 128 * g + 8 * hi;
      const bf16* Pp0 = (const bf16*)(C.ws + A_PREV) + ((size_t)(c * 32 + hh) * 64 + r32) * 128 + 8 * hi; const bf16* Pp1 = Pp0 + 32 * 128;
#pragma unroll 1
      for (int kh = 0; kh < 2; ++kh) {
          v4u ca[4], pb0[4], pb1[4];
#pragma unroll
          for (int ks = 0; ks < 4; ++ks) { ca[ks] = *(const v4u*)(Cp + 64 * kh + 16 * ks); pb0[ks] = *(const v4u*)(Pp0 + 64 * kh + 16 * ks); pb1[ks] = *(const v4u*)(Pp1 + 64 * kh + 16 * ks); }
#pragma unroll
          for (int ks = 0; ks < 4; ++ks) { float f[8]; UNPACK8(ca[ks], f);
#pragma unroll
              for (int e = 0; e < 8; ++e) f[e] *= ea;
              const v4u a2 = PACK8(f);
              acc0 = MFMA32(a2, pb0[ks], acc0); acc1 = MFMA32(a2, pb1[ks], acc1); } } }
    const float Dh = C.in[IN_SSDD][l * 32 + hh];
#pragma unroll
    for (int i = 0; i < 4; ++i) { const int id = C.lane + 64 * i; *(v4u*)(slot + id * 8) = xt[i]; }
    asm volatile("s_waitcnt lgkmcnt(0)" ::: "memory");
    float xv0[16], xv1[16];
#pragma unroll
    for (int r = 0; r < 16; ++r) { const int rr = crow(r, hi); xv0[r] = bf2f(slot[rr * 64 + r32]); xv1[r] = bf2f(slot[rr * 64 + 32 + r32]); }
    asm volatile("s_waitcnt lgkmcnt(0)" ::: "memory");
#pragma unroll
    for (int i = 0; i < 4; ++i) { const int id = C.lane + 64 * i; *(v4u*)(slot + id * 8) = zt[i]; }
    asm volatile("s_waitcnt lgkmcnt(0)" ::: "memory");
#pragma unroll
    for (int r = 0; r < 16; ++r) { const int rr = crow(r, hi);
        const float z0 = bf2f(slot[rr * 64 + r32]), z1 = bf2f(slot[rr * 64 + 32 + r32]);
        const float y0 = (acc0[r] + Dh * xv0[r]) * silu_f(z0), y1 = (acc1[r] + Dh * xv1[r]) * silu_f(z1);
        const unsigned w2 = cvtpk(y0, y1);
        slot[rr * 64 + r32] = (bf16)(w2 & 0xffffu); slot[rr * 64 + 32 + r32] = (bf16)(w2 >> 16);
        float s2 = y0 * y0 + y1 * y1;
        s2 += __shfl_xor(s2, 1); s2 += __shfl_xor(s2, 2); s2 += __shfl_xor(s2, 4); s2 += __shfl_xor(s2, 8); s2 += __shfl_xor(s2, 16);
        if (r32 == 0) ssq_row[rr * 8] = s2; }
    asm volatile("s_waitcnt lgkmcnt(0)" ::: "memory");
}
__device__ __forceinline__ void merge_task(const bf16* PART, const float* ML, int t, f32x2 (&ml)[4], v4u (&pw)[4]) {
    const int q = t >> 7, h = (t >> 4) & 7, dc = t & 15; const int ns = 1 + ((q >> 8) < 3 ? (q >> 8) : 3);
#pragma unroll
    for (int s = 0; s < 4; ++s) { if (s < ns) { ml[s] = *(const f32x2*)(ML + (((size_t)s * S_ + q) * 8 + h) * 2); pw[s] = *(const v4u*)(PART + ((size_t)s * S_ + q) * AW + h * 128 + dc * 8); }
        else { ml[s] = (f32x2){-1e30f, 0.f}; pw[s] = (v4u){0u, 0u, 0u, 0u}; } }
}
__device__ __forceinline__ void merge_finish(bf16* Y, int t, const f32x2 (&ml)[4], const v4u (&pw)[4]) {
    const int q = t >> 7, h = (t >> 4) & 7, dc = t & 15;
    const float M = fmaxf(fmaxf(ml[0].x, ml[1].x), fmaxf(ml[2].x, ml[3].x));
    float o[8], W = 0.f;
#pragma unroll
    for (int e = 0; e < 8; ++e) o[e] = 0.f;
#pragma unroll
    for (int s = 0; s < 4; ++s) { const float wgt = __builtin_amdgcn_exp2f(ml[s].x - M) * ml[s].y; W += wgt; float f[8]; UNPACK8(pw[s], f);
#pragma unroll
        for (int e = 0; e < 8; ++e) o[e] += wgt * f[e]; }
    const float rw = 1.0f / W;
#pragma unroll
    for (int e = 0; e < 8; ++e) o[e] *= rw;
    *(v4u*)(Y + (size_t)q * YCAT_LD + h * 128 + dc * 8) = PACK8(o);
}
__device__ __forceinline__ void attn_merge(const Ctx& C) {
    const bf16* PART = (const bf16*)(C.ws + A_PART); const float* ML = (const float*)(C.ws + WS_ML); bf16* Y = (bf16*)(C.ws + A_YCAT) + YC_ATTN;
    const int stride = C.G * NWAVES * 64;
    for (int t = C.bid * (NWAVES * 64) + C.tid; t < S_ * 128; t += 4 * stride) {
        f32x2 mlA[4], mlB[4], mlC[4], mlD[4]; v4u pwA[4], pwB[4], pwC[4], pwD[4]; const int tB = t + stride, tC = t + 2 * stride, tD = t + 3 * stride;
        const bool hasB = tB < S_ * 128, hasC = tC < S_ * 128, hasD = tD < S_ * 128;
        merge_task(PART, ML, t, mlA, pwA); if (hasB) merge_task(PART, ML, tB, mlB, pwB); if (hasC) merge_task(PART, ML, tC, mlC, pwC); if (hasD) merge_task(PART, ML, tD, mlD, pwD);
        merge_finish(Y, t, mlA, pwA); if (hasB) merge_finish(Y, tB, mlB, pwB); if (hasC) merge_finish(Y, tC, mlC, pwC); if (hasD) merge_finish(Y, tD, mlD, pwD);
    }
}
__device__ __forceinline__ void ph_ssd_out(const Ctx& C, int l) {
    float* ssq = (float*)(C.lds + SCR_OFF); float* rstdL = ssq + 1024;
    const int r32 = C.lane & 31, hi = C.lane >> 5;
    for (int u = C.bid; u < 256; u += C.G) { const int c = u >> 3, g = (u >> 1) & 3, hf = u & 1, hh = 8 * g + C.wave;
        bf16* slots = (bf16*)(C.lds + C.wave * 16384);
#pragma unroll 1
        for (int i = 0; i < 4; ++i) { const int rt = hf ? (i == 0 ? 1 : i == 1 ? 2 : i == 2 ? 5 : 6) : (i == 0 ? 0 : i == 1 ? 3 : i == 2 ? 4 : 7);
            ssd_tile(C, l, c, hh, rt, slots + i * 2048, ssq + i * 256 + C.wave); }
        __syncthreads();
        if (C.tid < 128) { const f32x4 a = *(const f32x4*)(ssq + C.tid * 8), b = *(const f32x4*)(ssq + C.tid * 8 + 4);
            rstdL[C.tid] = rsqrtf((((a[0] + a[1]) + (a[2] + a[3])) + ((b[0] + b[1]) + (b[2] + b[3]))) * (1.0f / 512.0f) + EPS); }
        __syncthreads();
        bf16* YS = (bf16*)(C.ws + A_YCAT) + YC_SSD;
#pragma unroll 1
        for (int i = 0; i < 4; ++i) { const int rt = hf ? (i == 0 ? 1 : i == 1 ? 2 : i == 2 ? 5 : 6) : (i == 0 ? 0 : i == 1 ? 3 : i == 2 ? 4 : 7); bf16* yt = slots + i * 2048;
#pragma unroll
            for (int r = 0; r < 16; ++r) { const int rr = crow(r, hi); const float rs = rstdL[i * 32 + rr];
                const unsigned w2 = cvtpk(bf2f(yt[rr * 64 + r32]) * rs, bf2f(yt[rr * 64 + 32 + r32]) * rs);
                yt[rr * 64 + r32] = (bf16)(w2 & 0xffffu); yt[rr * 64 + 32 + r32] = (bf16)(w2 >> 16); }
            asm volatile("s_waitcnt lgkmcnt(0)" ::: "memory");
#pragma unroll
            for (int k = 0; k < 4; ++k) { const int id = C.lane + 64 * k, row = id >> 3, ch = id & 7;
                *(v4u*)(YS + (size_t)(256 * c + 32 * rt + row) * YCAT_LD + 64 * hh + ch * 8) = *(const v4u*)(yt + id * 8); } }
        __syncthreads();
    }
    attn_merge(C);
}

struct Args { const float* in[21]; float* out; unsigned char* ws; int pad0, pad1; };
static_assert(sizeof(Args) == 21 * 8 + 8 + 8 + 8, "Args has no padding");
typedef __attribute__((address_space(4))) const Args* CArgsP;
#define MKCTX() Ctx C; { CArgsP ap_ = (CArgsP)__builtin_amdgcn_kernarg_segment_ptr(); asm volatile("" : "+s"(ap_)); \
        C.lds = lds; C.tid = threadIdx.x; asm volatile("" : "+v"(C.tid)); C.lane = C.tid & 63; C.wave = __builtin_amdgcn_readfirstlane(C.tid >> 6); C.G = gridDim.x; C.bid = blockIdx.x; \
        _Pragma("unroll") for (int i_ = 0; i_ < 21; ++i_) C.in[i_] = (const float*)(const GAS float*)ap_->in[i_]; C.out = (float*)(GAS float*)ap_->out; C.ws = (unsigned char*)(GAS unsigned char*)ap_->ws; }
#define LAYER_PTRS() unsigned char* wl = C.ws + WS_W + (size_t)l * LAYER_W; const float* ada = (const float*)(C.ws + WS_ADA) + l * NADA; float* rowss = (float*)(C.ws + WS_RSP); bf16* XB = (bf16*)(C.ws + WS_XB); unsigned char* XB8 = C.ws + WS_XB8; (void)XB8; (void)wl; (void)ada; (void)rowss; (void)XB
#ifndef PHMASK
#define PHMASK 0xFFFF
#endif
#define KON(kd) (((PHMASK) >> (kd)) & 1)
#ifndef REP_CONV
#define REP_CONV 1
#endif
#define SEAM() xcd_barrier(bar)
#define RS_IN (STREAM_BF16 ? 8 : 0)
#define RS_F32 (STREAM_BF16 ? 0 : 16)
template <int l> __device__ __forceinline__ void layer_body(unsigned char* lds, LAS unsigned char* ldsl, const XcdBarrier& bar) {
    if (KON(2)) { MKCTX(); LAYER_PTRS(); pg8::Gemm g{(const bf16*)XB, (const bf16*)(wl + W_IN), S_, FF2, DM}; pg8::StaticOrder S; S.init(S_, FF2, C.G, C.bid);
        pg8::EpiSwiGLU<false> E{(bf16*)(C.ws + A_HID), (const float*)(C.ws + WS_BIASIN) + (size_t)(l * 2 + 0) * FF2, rowss, FF, ldsl};
        pg8::gemm_phase<pg8::EpiSwiGLU<false>, pg8::StaticOrder, true, true, false>(ldsl, g, S, E);
        { int iw, niw; tail_waves(C, (S_ / 256) * (FF2 / 256), iw, niw); if (niw) convert_tail(C, l, 0, iw, niw); } }
    SEAM();
    if (KON(3)) { MKCTX(); LAYER_PTRS(); pg8::Gemm g{(const bf16*)(C.ws + A_HID), (const bf16*)(wl + W_OUT), S_, DM, FF}; pg8::StaticOrder S; S.init(S_, DM, C.G, C.bid);
        pg8::EpiResid E{l == 0 ? C.in[IN_X] : C.out, C.out, XB, XB8, ada + (0 * 3 + 2) * 2048, rowss, 0.5f, (MIX_GATE_FP8 && l == 1 ? 3 : 1) | 4 | RS_IN | RS_F32};
        pg8::gemm_phase<pg8::EpiResid, pg8::StaticOrder, true, true, false>(ldsl, g, S, E); }
    SEAM();
    constexpr bool G8 = MIX_GATE_FP8 && l == 1;
    if (KON(4)) { MKCTX(); LAYER_PTRS(); constexpr int NB = G8 ? MC_GA : NMIX;
        { pg8::Gemm g{XB, (const bf16*)(wl + W_MIX), S_, NB, DM}; pg8::StaticOrder S; S.init(S_, NB, C.G, C.bid);
          pg8::EpiMix E{(bf16*)(C.ws + A_MIX), (const float*)(C.ws + WS_BIASMIX) + (size_t)l * NMIX, rowss, NMIX, MC_GA / 256, 0, ldsl};
          pg8::gemm_phase<pg8::EpiMix, pg8::StaticOrder, true, true>(ldsl, g, S, E); }
        { int iw, niw; tail_waves(C, (S_ / 256) * (NB / 256), iw, niw); if (niw) convert_tail(C, l, 1, iw, niw); }
        if constexpr (G8) { __syncthreads();
          pg8::Gemm g{(const bf16*)XB8, (const bf16*)(wl + W_MIX + (size_t)MC_GA * DM * 2), S_, NMIX - MC_GA, DM / 2}; pg8::StaticOrder S; S.init(S_, NMIX - MC_GA, C.G, C.bid);
          pg8::EpiMix E{(bf16*)(C.ws + A_MIX), (const float*)(C.ws + WS_BIASMIX) + (size_t)l * NMIX, rowss, NMIX, 0, MC_GA, ldsl};
          pg8::gemm_phase<pg8::EpiMix, pg8::StaticOrder, true, true, true>(ldsl, g, S, E); } }
    SEAM();
    if (KON(5)) { { MKCTX(); ph_prep_qk(C, l); } { MKCTX(); ph_prep_ssd(C, l); } { MKCTX(); ph_prep_conv(C, l); } } SEAM();
    if (KON(6)) { MKCTX(); ph_select(C, l); } SEAM();
    if (KON(7)) { MKCTX(); ph_attn(C, l, 0); } SEAM();
    if (KON(8)) { MKCTX(); ph_ssd_out(C, l); } SEAM();
    if (KON(10)) { MKCTX(); LAYER_PTRS(); pg8::StaticOrder S; S.init(S_, DM, C.G, C.bid); const bf16* MIX = (const bf16*)(C.ws + A_MIX);
        pg8::Gemm g{(const bf16*)(C.ws + A_YCAT), (const bf16*)(wl + W_BA), S_, DM, YCAT_LD}; pg8::EpiBrCat E{MIX + MC_GA, MIX + MC_GS, MIX + MC_GC, NMIX, (bf16*)(C.ws + A_MRG)};
        pg8::gemm_phase<pg8::EpiBrCat, pg8::StaticOrder, true, true>(ldsl, g, S, E); }
    SEAM();
    constexpr bool F8 = LAST_FFN_FP8 && l == 1;
    if (KON(11)) { MKCTX(); LAYER_PTRS(); pg8::Gemm g{(const bf16*)(C.ws + A_MRG), (const bf16*)(wl + W_MO), S_, DM, DM}; pg8::StaticOrder S; S.init(S_, DM, C.G, C.bid);
        pg8::EpiResid E{C.out, C.out, XB, XB8, ada + (1 * 3 + 2) * 2048, rowss, 1.0f, (F8 ? (STREAM_BF16 ? 3 : 2) : 1) | 4 | RS_IN | RS_F32};
        pg8::gemm_phase<pg8::EpiResid, pg8::StaticOrder, true, true>(ldsl, g, S, E); }
    SEAM();
    if (KON(2)) { MKCTX(); LAYER_PTRS(); pg8::Gemm g{F8 ? (const bf16*)XB8 : (const bf16*)XB, (const bf16*)(wl + W_IN + W_IN_SZ), S_, FF2, F8 ? DM / 2 : DM}; pg8::StaticOrder S; S.init(S_, FF2, C.G, C.bid);
        pg8::EpiSwiGLU<F8> E{(bf16*)(C.ws + A_HID), (const float*)(C.ws + WS_BIASIN) + (size_t)(l * 2 + 1) * FF2, rowss, FF, ldsl};
        pg8::gemm_phase<pg8::EpiSwiGLU<F8>, pg8::StaticOrder, true, true, F8>(ldsl, g, S, E);
        { int iw, niw; tail_waves(C, (S_ / 256) * (FF2 / 256), iw, niw); if (niw) convert_tail(C, l, 2, iw, niw); } }
    SEAM();
    if (KON(3)) { MKCTX(); LAYER_PTRS(); pg8::Gemm g{(const bf16*)(C.ws + A_HID), (const bf16*)(wl + W_OUT + W_OUT_SZ), S_, DM, F8 ? FF / 2 : FF}; pg8::StaticOrder S; S.init(S_, DM, C.G, C.bid);
        pg8::EpiResid E{C.out, C.out, XB, XB8, ada + (2 * 3 + 2) * 2048, rowss, 0.5f, (l == 0 ? (1 | 4 | RS_F32) : 16) | RS_IN};
        pg8::gemm_phase<pg8::EpiResid, pg8::StaticOrder, true, true, F8>(ldsl, g, S, E); }
}
__global__ void __launch_bounds__(NWAVES * 64, 2) hybrid_fwd(Args args) {
    extern __shared__ __attribute__((aligned(16))) unsigned char lds[];
    const int tid0 = threadIdx.x;
    LAS unsigned char* ldsl = (LAS unsigned char*)lds;
    volatile LAS unsigned* MISC = (volatile LAS unsigned*)(ldsl + MISC_OFF);
    for (int u = tid0; u < 64; u += NWAVES * 64) ((LAS unsigned*)(ldsl + MISC_OFF))[u] = 0u;
    __syncthreads();
    gu32* ctl = (gu32*)(args.ws + WS_CTL);
    XcdBarrier bar = xcd_barrier_post((unsigned*)(ctl + CW_BAR), MISC + 8);
    if (KON(0)) { MKCTX(); ph_ada(C); } SEAM();
    if (KON(1)) { MKCTX(); ph_convert(C); } SEAM();
    if (REP_CONV > 1) { { MKCTX(); ph_convert(C); } SEAM(); }
    layer_body<0>(lds, ldsl, bar);
    SEAM();
    layer_body<1>(lds, ldsl, bar);
}

extern "C" void kernel_launch(void* const* d_in, const int* in_sizes, int n_in, void* d_out, int out_size, void* d_ws, size_t ws_size, hipStream_t stream) {
    static int grid = 0;
    if (grid == 0) {
        if (n_in != 21 || in_sizes[0] != S_ * DM || out_size != S_ * DM || ws_size < WS_END) {
            fprintf(stderr, "kernel_launch: unexpected shapes (n_in %d, in0 %d, out %d, ws %zu, need %zu); nothing launched\n", n_in, n_in > 0 ? in_sizes[0] : -1, out_size, ws_size, (size_t)WS_END); grid = -1; return; }
        int dev = 0, cus = 0, per_cu = 0;
        if (hipGetDevice(&dev) != hipSuccess || hipDeviceGetAttribute(&cus, hipDeviceAttributeMultiprocessorCount, dev) != hipSuccess || cus <= 0) { fprintf(stderr, "kernel_launch: device query failed\n"); grid = -1; return; }
        if (hipFuncSetAttribute((const void*)hybrid_fwd, hipFuncAttributeMaxDynamicSharedMemorySize, LDS_BYTES) != hipSuccess) { fprintf(stderr, "kernel_launch: hipFuncSetAttribute failed\n"); grid = -1; return; }
        if (hipOccupancyMaxActiveBlocksPerMultiprocessor(&per_cu, (const void*)hybrid_fwd, NWAVES * 64, LDS_BYTES) != hipSuccess || per_cu < 1)
            fprintf(stderr, "kernel_launch: note: occupancy query reports %d workgroups per CU\n", per_cu);
        (void)hipGetLastError();
        grid = cus;
    }
    if (grid < 0) return;
    if (hipMemsetAsync((char*)d_ws, 0, ZERO_BYTES, stream) != hipSuccess) { fprintf(stderr, "kernel_launch: memset failed\n"); return; }
    Args a{};
    for (int i = 0; i < 21; ++i) a.in[i] = (const float*)d_in[i];
    a.out = (float*)d_out; a.ws = (unsigned char*)d_ws;
    hipLaunchKernelGGL(hybrid_fwd, dim3(grid), dim3(NWAVES * 64), LDS_BYTES, stream, a);
    const hipError_t le = hipPeekAtLastError();
    if (le != hipSuccess) fprintf(stderr, "kernel_launch: launch failed: %s\n", hipGetErrorName(le));
}
```

```cpp
#include <hip/hip_runtime.h>
#include <cstdio>
#include <cstdint>
namespace pg8 {
#define PG8_LAS __attribute__((address_space(3)))
typedef unsigned short bf16_t;
typedef short bf16x8 __attribute__((ext_vector_type(8)));
typedef float f32x4 __attribute__((ext_vector_type(4)));
typedef unsigned u32x4 __attribute__((ext_vector_type(4)));
typedef int i32x4 __attribute__((ext_vector_type(4)));
typedef float f32x32 __attribute__((ext_vector_type(32)));
typedef int i32x8 __attribute__((ext_vector_type(8)));
constexpr int BM = 256, BK = 64, HALF = 128, HTB = HALF * BK * 2  , STAGE_BYTES = 8 * HTB, NXCD = 8, WGM = 8;

__host__ __device__ __forceinline__ int lds_byte(int r, int c) { const int st = (r >> 4) * 2 + (c >> 5), rr = r & 15, cc = c & 31, ob = rr * 64 + cc * 2; return st * 1024 + (ob ^ (((ob >> 9) & 1) << 5)); }
__host__ __device__ __forceinline__ void stage_rc(int b, int& R, int& C) { const int st = b / 1024, sb = b % 1024, swz = sb ^ (((sb >> 9) & 1) << 5); R = (st >> 1) * 16 + swz / 64; C = (st & 1) * 32 + (swz % 64) / 2; }
__host__ __device__ __forceinline__ int perm32(int rho) { const int n = rho >> 4, i = rho & 15; return 8 * (i >> 2) + 4 * n + (i & 3); }

struct Unit { int pm, pn; int par = 0; };
struct Gemm { const bf16_t* A; const bf16_t* Bt; int M, N, K; int sa = 0x7f7f7f7f, sb = 0x7f7f7f7f; int nt_probe = 0; };

struct StaticOrder {
    int nM, nN, nwg, G, c;
    __host__ __device__ void init(int M, int N, int G_, int c_) { nM = M / BM; nN = N / BM; nwg = nM * nN; G = G_; c = c_; }
    __host__ __device__ bool next(int i, Unit& u) const {
        const long L = (long)i * G + c; if (L >= nwg) return false;
        int wgid = (int)L; { const int q = nwg / NXCD, r = nwg % NXCD, xcd = wgid % NXCD, off = wgid / NXCD; wgid = (xcd < r ? xcd * (q + 1) : r * (q + 1) + (xcd - r) * q) + off; }
        const int nig = WGM * nN, gid = wgid / nig, fm = gid * WGM, gsz = (nM - fm) < WGM ? (nM - fm) : WGM;
        u.pm = fm + ((wgid % nig) % gsz); u.pn = (wgid % nig) / gsz; return true;
    }
    __device__ __forceinline__ void a_ready(const Unit&) const {}
    __device__ __forceinline__ void done(const Unit&) const {}
};

__device__ __forceinline__ unsigned cvt_pk_bf16(float lo, float hi) { unsigned r; asm volatile("v_cvt_pk_bf16_f32 %0, %1, %2" : "=v"(r) : "v"(lo), "v"(hi)); return r; }
typedef float f32x2 __attribute__((ext_vector_type(2)));
__device__ __forceinline__ float fast_sigmoid(float v) { return __builtin_amdgcn_rcpf(1.0f + __expf(-v)); }
__device__ __forceinline__ float fast_silu(float v) { return v * fast_sigmoid(v); }
__device__ __forceinline__ f32x4 unpack_lo(unsigned a, unsigned b) { return (f32x4){__uint_as_float(a << 16), __uint_as_float(a & 0xffff0000u), __uint_as_float(b << 16), __uint_as_float(b & 0xffff0000u)}; }
constexpr float NORM_EPS = 1e-6f;
__device__ __forceinline__ unsigned pk4_fp8(float a, float b, float c, float d) {
    a = __builtin_amdgcn_fmed3f(a, -448.f, 448.f); b = __builtin_amdgcn_fmed3f(b, -448.f, 448.f); c = __builtin_amdgcn_fmed3f(c, -448.f, 448.f); d = __builtin_amdgcn_fmed3f(d, -448.f, 448.f);
    int w = 0; w = __builtin_amdgcn_cvt_pk_fp8_f32(a, b, w, false); w = __builtin_amdgcn_cvt_pk_fp8_f32(c, d, w, true); return (unsigned)w;
}
typedef unsigned u32x2 __attribute__((ext_vector_type(2)));
constexpr int PG8_BIAS_QF = 336 * 1024 / 4;
constexpr float XS8 = 4.0f, HS8 = 8.0f, WS8 = 64.0f;
constexpr int E8_X = 0x7d7d7d7d, E8_H = 0x7c7c7c7c, E8_W = 0x79797979;
constexpr int RST_OFF = STAGE_BYTES + 22528;
constexpr int BIAS_OFF = STAGE_BYTES + 20480;
struct RstdLoads { f32x4 a, b, c, d; float e, f; };
__device__ __forceinline__ void rstd_issue(const float* rsp, const float* bias0, const Unit& u, RstdLoads& L) {
    int t = threadIdx.x; asm volatile("" : "+v"(t)); const int row = t >> 1, hf = t & 1;
    const f32x4* p = (const f32x4*)(rsp + (size_t)(u.pm * BM + row) * 32 + hf * 16);
    L.a = p[0]; L.b = p[1]; L.c = p[2]; L.d = p[3];
    const float* bp = bias0 + (2 * hf) * PG8_BIAS_QF + row;
    L.e = bp[0]; L.f = bp[PG8_BIAS_QF];
}
__device__ __forceinline__ void rstd_finish(const Unit& u, PG8_LAS unsigned char* lds, const RstdLoads& L) {
    int t = threadIdx.x; asm volatile("" : "+v"(t)); const int row = t >> 1, hf = t & 1;
    const f32x4 a = L.a, b = L.b, c = L.c, d = L.d;
    float s = (((a[0] + a[1]) + (a[2] + a[3])) + ((b[0] + b[1]) + (b[2] + b[3]))) + (((c[0] + c[1]) + (c[2] + c[3])) + ((d[0] + d[1]) + (d[2] + d[3])));
    const float o = __shfl_xor(s, 1); s = hf ? o + s : s + o;
    if (hf == 0) ((PG8_LAS float*)(lds + RST_OFF))[u.par * 256 + row] = rsqrtf(s * (1.0f / 2048.0f) + NORM_EPS);
    float bs = L.e + L.f; const float bo = __shfl_xor(bs, 1); bs = hf ? bo + bs : bs + bo;
    if (hf == 0) ((PG8_LAS float*)(lds + BIAS_OFF))[u.par * 256 + row] = bs;
}
template <bool F8OUT> struct EpiSwiGLU {
    static constexpr bool PERM = true, AFTER_DRAIN = false, PRE = true, MID = false; static constexpr int SA = E8_W, SB = E8_X;
    bf16_t* O; const float* bias; const float* rsp; int ldo; PG8_LAS unsigned char* ldsb;
    __device__ __forceinline__ void pre_issue(const Unit& u, RstdLoads& L) const { rstd_issue(rsp, bias + u.pn * BM, u, L); }
    __device__ __forceinline__ void pre_finish(const Unit& u, PG8_LAS unsigned char* lds, const RstdLoads& L) const { rstd_finish(u, lds, L); }
    __device__ __forceinline__ void operator()(const f32x4 (&acc)[2][2][4][2], const Unit& u, int wr, int wc, int fr_, int fq_) const {
        int lane_ = (int)__builtin_amdgcn_mbcnt_hi(~0u, __builtin_amdgcn_mbcnt_lo(~0u, 0u)); asm volatile("" : "+v"(lane_));
        const int fr = lane_ & 15, fq = lane_ >> 4; (void)fr_; (void)fq_;
        const int row0 = u.pm * BM + wr * 64 + fr, bcol0 = u.pn * BM + wc * 32 + 8 * fq, ocol0 = u.pn * HALF + wc * 32 + 8 * fq;
        float rs[8]; f32x4 bg[2], bu[2];
#pragma unroll
        for (int i = 0; i < 8; ++i) rs[i] = ((const PG8_LAS float*)(ldsb + RST_OFF))[u.par * 256 + wr * 64 + fr + (i >> 2) * HALF + (i & 3) * 16];
#pragma unroll
        for (int n = 0; n < 2; ++n) { const PG8_LAS float* bt = (const PG8_LAS float*)(ldsb + BIAS_OFF) + u.par * 256 + wc * 32 + 8 * fq + 4 * n; bg[n] = *(const PG8_LAS f32x4*)bt; bu[n] = *(const PG8_LAS f32x4*)(bt + HALF); }
#pragma unroll
        for (int ai = 0; ai < 2; ++ai)
#pragma unroll
            for (int m = 0; m < 4; ++m) { const int r = row0 + ai * HALF + m * 16; const float rsv = rs[ai * 4 + m];
                f32x4 h[2];
#pragma unroll
                for (int n = 0; n < 2; ++n) { const f32x4 g = acc[ai][0][m][n] * rsv + bg[n], up = acc[ai][1][m][n] * rsv + bu[n];
                    h[n] = (f32x4){fast_silu(g[0]) * up[0], fast_silu(g[1]) * up[1], fast_silu(g[2]) * up[2], fast_silu(g[3]) * up[3]}; }
                if constexpr (F8OUT) { u32x2 w; w.x = pk4_fp8(h[0][0] * HS8, h[0][1] * HS8, h[0][2] * HS8, h[0][3] * HS8); w.y = pk4_fp8(h[1][0] * HS8, h[1][1] * HS8, h[1][2] * HS8, h[1][3] * HS8);
                    *(u32x2*)((unsigned char*)O + (size_t)r * ldo + ocol0) = w; }
                else { u32x4 w; w.x = cvt_pk_bf16(h[0][0], h[0][1]); w.y = cvt_pk_bf16(h[0][2], h[0][3]); w.z = cvt_pk_bf16(h[1][0], h[1][1]); w.w = cvt_pk_bf16(h[1][2], h[1][3]);
                    *(u32x4*)(O + (size_t)r * ldo + ocol0) = w; } }
    }
};
struct EpiResid {
    static constexpr bool PERM = true, AFTER_DRAIN = false, PRE = false, MID = false; static constexpr int SA = E8_W, SB = E8_H;
    const float* xin; float* xout; bf16_t* xb; unsigned char* xb8; const float* gate; float* rsp_next; float wgt; int flags;
    __device__ __forceinline__ void operator()(const f32x4 (&acc)[2][2][4][2], const Unit& u, int wr, int wc, int fr_, int fq_) const {
        int lane_ = (int)__builtin_amdgcn_mbcnt_hi(~0u, __builtin_amdgcn_mbcnt_lo(~0u, 0u)); asm volatile("" : "+v"(lane_));
        const int fr = lane_ & 15, fq = lane_ >> 4; (void)fr_; (void)fq_;
        const int row0 = u.pm * BM + wr * 64 + fr, col0 = u.pn * BM + wc * 32 + 8 * fq;
#pragma unroll
        for (int hb = 0; hb < 4; ++hb) { f32x4 xv[2][2][2]; f32x4 gt[2][2];
#pragma unroll
            for (int bj = 0; bj < 2; ++bj)
#pragma unroll
                for (int n = 0; n < 2; ++n) gt[bj][n] = *(const f32x4*)(gate + col0 + bj * HALF + 4 * n) * wgt;
#pragma unroll
            for (int mm = 0; mm < 2; ++mm)
#pragma unroll
                for (int bj = 0; bj < 2; ++bj) { const size_t off = (size_t)(row0 + (hb >> 1) * HALF + ((hb & 1) * 2 + mm) * 16) * 2048 + col0 + bj * HALF; if (flags & 8) { const u32x4 w = *(const u32x4*)(xb + off); xv[mm][bj][0] = (f32x4){__uint_as_float(w.x << 16), __uint_as_float(w.x & 0xffff0000u), __uint_as_float(w.y << 16), __uint_as_float(w.y & 0xffff0000u)};
                        xv[mm][bj][1] = (f32x4){__uint_as_float(w.z << 16), __uint_as_float(w.z & 0xffff0000u), __uint_as_float(w.w << 16), __uint_as_float(w.w & 0xffff0000u)}; }
                    else { xv[mm][bj][0] = *(const f32x4*)(xin + off); xv[mm][bj][1] = *(const f32x4*)(xin + off + 4); } }
#pragma unroll
            for (int mm = 0; mm < 2; ++mm) { const int ai = hb >> 1, m = (hb & 1) * 2 + mm; const int r = row0 + ai * HALF + m * 16; float ss = 0.f;
#pragma unroll
                for (int bj = 0; bj < 2; ++bj) { const size_t off = (size_t)r * 2048 + col0 + bj * HALF;
                    const f32x4 x0 = xv[mm][bj][0] + gt[bj][0] * acc[ai][bj][m][0], x1 = xv[mm][bj][1] + gt[bj][1] * acc[ai][bj][m][1];
                    if (flags & 16) { *(f32x4*)(xout + off) = x0; *(f32x4*)(xout + off + 4) = x1; }
                    if (flags & 1) { u32x4 w; w.x = cvt_pk_bf16(x0[0], x0[1]); w.y = cvt_pk_bf16(x0[2], x0[3]); w.z = cvt_pk_bf16(x1[0], x1[1]); w.w = cvt_pk_bf16(x1[2], x1[3]);
                        *(u32x4*)(xb + off) = w; }
                    if (flags & 2) { u32x2 w; w.x = pk4_fp8(x0[0] * XS8, x0[1] * XS8, x0[2] * XS8, x0[3] * XS8); w.y = pk4_fp8(x1[0] * XS8, x1[1] * XS8, x1[2] * XS8, x1[3] * XS8);
                        *(u32x2*)(xb8 + off) = w; }
                    ss += (x0[0] * x0[0] + x0[1] * x0[1]) + (x0[2] * x0[2] + x0[3] * x0[3]) + (x1[0] * x1[0] + x1[1] * x1[1]) + (x1[2] * x1[2] + x1[3] * x1[3]); }
                ss += __shfl_xor(ss, 16); ss += __shfl_xor(ss, 32);
                if ((flags & 4) && fq == 0) rsp_next[(size_t)r * 32 + u.pn * 4 + wc] = ss; } }
    }
};
struct EpiMix {
    static constexpr bool PERM = true, AFTER_DRAIN = false, PRE = true, MID = false; static constexpr int SA = E8_W, SB = E8_X;
    bf16_t* O; const float* bias; const float* rsp; int ldo; int sig_tile; int coff; PG8_LAS unsigned char* ldsb;
    __device__ __forceinline__ void pre_issue(const Unit& u, RstdLoads& L) const { rstd_issue(rsp, bias + coff + u.pn * BM, u, L); }
    __device__ __forceinline__ void pre_finish(const Unit& u, PG8_LAS unsigned char* lds, const RstdLoads& L) const { rstd_finish(u, lds, L); }
    __device__ __forceinline__ void operator()(const f32x4 (&acc)[2][2][4][2], const Unit& u, int wr, int wc, int fr_, int fq_) const {
        int lane_ = (int)__builtin_amdgcn_mbcnt_hi(~0u, __builtin_amdgcn_mbcnt_lo(~0u, 0u)); asm volatile("" : "+v"(lane_));
        const int fr = lane_ & 15, fq = lane_ >> 4; (void)fr_; (void)fq_;
        const int row0 = u.pm * BM + wr * 64 + fr, col0 = coff + u.pn * BM + wc * 32 + 8 * fq; const bool sig = u.pn >= sig_tile;
        float rs[8]; f32x4 bv[2][2];
#pragma unroll
        for (int i = 0; i < 8; ++i) rs[i] = ((const PG8_LAS float*)(ldsb + RST_OFF))[u.par * 256 + wr * 64 + fr + (i >> 2) * HALF + (i & 3) * 16];
#pragma unroll
        for (int bj = 0; bj < 2; ++bj)
#pragma unroll
            for (int n = 0; n < 2; ++n) bv[bj][n] = *(const PG8_LAS f32x4*)((const PG8_LAS float*)(ldsb + BIAS_OFF) + u.par * 256 + wc * 32 + 8 * fq + bj * HALF + 4 * n);
#pragma unroll
        for (int ai = 0; ai < 2; ++ai)
#pragma unroll
            for (int m = 0; m < 4; ++m) { const int r = row0 + ai * HALF + m * 16; const float rsv = rs[ai * 4 + m];
#pragma unroll
                for (int bj = 0; bj < 2; ++bj) { f32x4 v0 = acc[ai][bj][m][0] * rsv + bv[bj][0], v1 = acc[ai][bj][m][1] * rsv + bv[bj][1];
                    if (sig) { v0 = (f32x4){fast_sigmoid(v0[0]), fast_sigmoid(v0[1]), fast_sigmoid(v0[2]), fast_sigmoid(v0[3])}; v1 = (f32x4){fast_sigmoid(v1[0]), fast_sigmoid(v1[1]), fast_sigmoid(v1[2]), fast_sigmoid(v1[3])}; }
                    u32x4 w; w.x = cvt_pk_bf16(v0[0], v0[1]); w.y = cvt_pk_bf16(v0[2], v0[3]); w.z = cvt_pk_bf16(v1[0], v1[1]); w.w = cvt_pk_bf16(v1[2], v1[3]);
                    *(u32x4*)(O + (size_t)r * ldo + col0 + bj * HALF) = w; } }
    }
};
struct EpiBrCat {
    static constexpr bool PERM = true, AFTER_DRAIN = false, PRE = false, MID = true; static constexpr int SA = 0, SB = 0, MID0 = 16, MID1 = 48;
    const bf16_t* ga; const bf16_t* gs; const bf16_t* gc; int ldg; bf16_t* outb;
    static __device__ __forceinline__ f32x4 gfloor(f32x4 v) { return (f32x4){fmaxf(v[0], 1e-20f), fmaxf(v[1], 1e-20f), fmaxf(v[2], 1e-20f), fmaxf(v[3], 1e-20f)}; }
    static __device__ __forceinline__ f32x4 rcp4(f32x4 v) { return (f32x4){__builtin_amdgcn_rcpf(v[0]), __builtin_amdgcn_rcpf(v[1]), __builtin_amdgcn_rcpf(v[2]), __builtin_amdgcn_rcpf(v[3])}; }
    __device__ __forceinline__ void mid(f32x4 (&acc)[2][2][4][2], const Unit& u, int seg, int wr, int wc) const {
        int lane_ = (int)__builtin_amdgcn_mbcnt_hi(~0u, __builtin_amdgcn_mbcnt_lo(~0u, 0u)); asm volatile("" : "+v"(lane_));
        const int fr = lane_ & 15, fq = lane_ >> 4; const int row0 = u.pm * BM + wr * 64 + fr, col0 = u.pn * BM + wc * 32 + 8 * fq;
        const bf16_t* gn = seg == 0 ? ga : gs; const bf16_t* gd = seg == 0 ? gs : gc;
#pragma unroll
        for (int ai = 0; ai < 2; ++ai) { u32x4 nv[4][2], dv[4][2];
#pragma unroll
            for (int m = 0; m < 4; ++m)
#pragma unroll
                for (int bj = 0; bj < 2; ++bj) { const int r = row0 + ai * HALF + m * 16; nv[m][bj] = *(const u32x4*)(gn + (size_t)r * ldg + col0 + bj * HALF); dv[m][bj] = *(const u32x4*)(gd + (size_t)r * ldg + col0 + bj * HALF); }
#pragma unroll
            for (int m = 0; m < 4; ++m)
#pragma unroll
                for (int bj = 0; bj < 2; ++bj) {
                    acc[ai][bj][m][0] = acc[ai][bj][m][0] * (gfloor(unpack_lo(nv[m][bj].x, nv[m][bj].y)) * rcp4(gfloor(unpack_lo(dv[m][bj].x, dv[m][bj].y))));
                    acc[ai][bj][m][1] = acc[ai][bj][m][1] * (gfloor(unpack_lo(nv[m][bj].z, nv[m][bj].w)) * rcp4(gfloor(unpack_lo(dv[m][bj].z, dv[m][bj].w)))); } }
    }
    __device__ __forceinline__ void operator()(const f32x4 (&acc)[2][2][4][2], const Unit& u, int wr, int wc, int fr_, int fq_) const {
        int lane_ = (int)__builtin_amdgcn_mbcnt_hi(~0u, __builtin_amdgcn_mbcnt_lo(~0u, 0u)); asm volatile("" : "+v"(lane_));
        const int fr = lane_ & 15, fq = lane_ >> 4; (void)fr_; (void)fq_;
        const int row0 = u.pm * BM + wr * 64 + fr, col0 = u.pn * BM + wc * 32 + 8 * fq;
        u32x4 gv[8][2];
#pragma unroll
        for (int i = 0; i < 8; ++i)
#pragma unroll
            for (int bj = 0; bj < 2; ++bj) gv[i][bj] = *(const u32x4*)(gc + (size_t)(row0 + (i >> 2) * HALF + (i & 3) * 16) * ldg + col0 + bj * HALF);
#pragma unroll
        for (int i = 0; i < 8; ++i) { const int ai = i >> 2, m = i & 3; const int r = row0 + ai * HALF + m * 16;
#pragma unroll
            for (int bj = 0; bj < 2; ++bj) { const size_t off = (size_t)r * 2048 + col0 + bj * HALF;
                const f32x4 v0 = acc[ai][bj][m][0] * gfloor(unpack_lo(gv[i][bj].x, gv[i][bj].y)), v1 = acc[ai][bj][m][1] * gfloor(unpack_lo(gv[i][bj].z, gv[i][bj].w));
                u32x4 w; w.x = cvt_pk_bf16(v0[0], v0[1]); w.y = cvt_pk_bf16(v0[2], v0[3]); w.z = cvt_pk_bf16(v1[0], v1[1]); w.w = cvt_pk_bf16(v1[2], v1[3]); *(u32x4*)(outb + off) = w; } }
    }
};

template <bool FP8> struct Frag { bf16x8 v[2]; };
template <> struct Frag<true> { i32x8 q; };
template <class Epi, class Sched, bool ALIGN_EPI = false, bool SP2 = false, bool FP8 = false>
__device__ __forceinline__ void gemm_phase(PG8_LAS unsigned char* lds, const Gemm g, const Sched& S, const Epi& E) {
    int tid_ = threadIdx.x; asm volatile("" : "+v"(tid_));
    const int tid = tid_, wid = __builtin_amdgcn_readfirstlane(tid >> 6), lane = tid & 63, wr = wid >> 2, wc = wid & 3, fr = lane & 15, fq = lane >> 4;
    const int K = g.K, nt = g.nt_probe > 0 ? g.nt_probe : K / BK;
    unsigned voffA[2], voffB[2];
#pragma unroll
    for (int i = 0; i < 2; ++i) { int R, C; stage_rc(tid * 16 + i * 8192, R, C); const int Rb = Epi::PERM ? ((R & ~31) + perm32(R & 31)) : R;
        voffA[i] = (unsigned)(R * K + C) * 2u; voffB[i] = (unsigned)(Rb * K + C) * 2u; }
    const size_t rstep64 = (size_t)64 * K * 2;
    const size_t kstep = (size_t)(BK * 2);
    const size_t hstep = (size_t)HALF * K * 2;
    const size_t tstep = 2 * hstep;
    const unsigned ldsw = (unsigned)wid * 1024u;
    const int aoff = lds_byte(wr * 64 + fr, fq * 8), boff = lds_byte(wc * 32 + fr, fq * 8);
    unsigned lda_ = (unsigned)(size_t)lds + (unsigned)aoff, ldb_ = (unsigned)(size_t)lds + 4u * HTB + (unsigned)boff; asm volatile("" : "+v"(lda_), "+v"(ldb_));
#define PG8_SA(b, h) (((b) * 2 + (h)) * HTB)
#define PG8_SB(b, h) ((4 + (b) * 2 + (h)) * HTB)
#define PG8_STAGE(bufoff, gbase, voff) do { _Pragma("unroll") for (int _i = 0; _i < 2; ++_i) \
        __builtin_amdgcn_global_load_lds((const unsigned*)((const char*)(gbase) + (size_t)_i * rstep64 + (voff)[0]), (PG8_LAS unsigned*)(lds + (bufoff) + ldsw + _i * 8192), 16, 0, 0); } while (0)
#define PG8_RA(b, h) (((b) * 2 + (h)) * HTB)
#define PG8_LDP(T, base, off) (*(const PG8_LAS T*)(PG8_LAS unsigned char*)(size_t)((base) + (unsigned)(off)))
#define PG8_LDA(dst, b, h) do { _Pragma("unroll") for (int m = 0; m < 4; ++m) { \
        if constexpr (FP8) dst[m].q = __builtin_shufflevector(PG8_LDP(i32x4, lda_, PG8_RA(b, h) + m * 2048), PG8_LDP(i32x4, lda_, PG8_RA(b, h) + m * 2048 + 1024), 0, 1, 2, 3, 4, 5, 6, 7); \
        else { _Pragma("unroll") for (int k = 0; k < 2; ++k) dst[m].v[k] = PG8_LDP(bf16x8, lda_, PG8_RA(b, h) + m * 2048 + k * 1024); } } } while (0)
#define PG8_LDB(dst, b, h) do { _Pragma("unroll") for (int n = 0; n < 2; ++n) { \
        if constexpr (FP8) dst[n].q = __builtin_shufflevector(PG8_LDP(i32x4, ldb_, PG8_RA(b, h) + n * 2048), PG8_LDP(i32x4, ldb_, PG8_RA(b, h) + n * 2048 + 1024), 0, 1, 2, 3, 4, 5, 6, 7); \
        else { _Pragma("unroll") for (int k = 0; k < 2; ++k) dst[n].v[k] = PG8_LDP(bf16x8, ldb_, PG8_RA(b, h) + n * 2048 + k * 1024); } } } while (0)
#ifndef PROBE_NOMMA
#define PROBE_NOMMA 0
#endif
#define PG8_MMA(ai, bj, At, Bt) do { if (PROBE_NOMMA && g.nt_probe > 0) break; __builtin_amdgcn_s_setprio(1); \
        if constexpr (FP8) { _Pragma("unroll") for (int m = 0; m < 4; ++m) _Pragma("unroll") for (int n = 0; n < 2; ++n) \
            { constexpr int dummy_ = 0; (void)dummy_; const int o_ = (m * 2 + n) * 4; \
              f32x4 c_ = (f32x4){accq[ai][bj][o_], accq[ai][bj][o_ + 1], accq[ai][bj][o_ + 2], accq[ai][bj][o_ + 3]}; \
              c_ = __builtin_amdgcn_mfma_scale_f32_16x16x128_f8f6f4(Bt[n].q, At[m].q, c_, 0, 0, 0, Epi::SA, 0, Epi::SB); \
              accq[ai][bj][o_] = c_[0]; accq[ai][bj][o_ + 1] = c_[1]; accq[ai][bj][o_ + 2] = c_[2]; accq[ai][bj][o_ + 3] = c_[3]; } } \
        else { _Pragma("unroll") for (int m = 0; m < 4; ++m) _Pragma("unroll") for (int n = 0; n < 2; ++n) _Pragma("unroll") for (int k = 0; k < 2; ++k) \
            acc[ai][bj][m][n] = __builtin_amdgcn_mfma_f32_16x16x32_bf16(Bt[n].v[k], At[m].v[k], acc[ai][bj][m][n], 0, 0, 0); } \
        __builtin_amdgcn_s_setprio(0); } while (0)
#define PG8_WAIT_V(n) asm volatile("s_waitcnt vmcnt(" #n ")" ::: "memory")
#define PG8_WAIT_L(n) asm volatile("s_waitcnt lgkmcnt(" #n ")" ::: "memory")
#define PG8_BAR __builtin_amdgcn_s_barrier()
#define PG8_SCHED __builtin_amdgcn_sched_barrier(0)
    Unit cur, nxt; int ui = 0;
    if (!S.next(0, cur)) return;
    f32x4 acc[2][2][4][2];
    f32x32 accq[2][2];
#pragma unroll
    for (int a = 0; a < 2; ++a)
#pragma unroll
        for (int b = 0; b < 2; ++b)
#pragma unroll
            for (int m = 0; m < 4; ++m)
#pragma unroll
                for (int n = 0; n < 2; ++n) { if constexpr (FP8) { _Pragma("unroll") for (int i_ = 0; i_ < 4; ++i_) accq[a][b][(m * 2 + n) * 4 + i_] = 0.f; } else acc[a][b][m][n] = (f32x4){0.f, 0.f, 0.f, 0.f}; }
    Frag<FP8> At[4], B0[2], B1[2];
    const char* cA = (const char*)g.A + (size_t)cur.pm * tstep; const char* cB = (const char*)g.Bt + (size_t)cur.pn * tstep;
    S.a_ready(cur);
    cur.par = 0;
    RstdLoads L0_; if constexpr (Epi::PRE) E.pre_issue(cur, L0_);
    if constexpr (SP2) {
        PG8_STAGE(PG8_SB(0, 0), cB, voffB); PG8_STAGE(PG8_SB(0, 1), cB + hstep, voffB); PG8_STAGE(PG8_SA(0, 0), cA, voffA); PG8_STAGE(PG8_SA(0, 1), cA + hstep, voffA);
        if (wr == 1) PG8_BAR;
        PG8_WAIT_V(2); PG8_BAR;
        PG8_STAGE(PG8_SB(1, 0), cB + kstep, voffB); PG8_STAGE(PG8_SA(1, 0), cA + kstep, voffA); PG8_STAGE(PG8_SB(1, 1), cB + hstep + kstep, voffB);
        PG8_WAIT_V(6); PG8_BAR;
    } else {
        PG8_STAGE(PG8_SB(0, 0), cB, voffB); PG8_STAGE(PG8_SA(0, 0), cA, voffA); PG8_STAGE(PG8_SB(0, 1), cB + hstep, voffB); PG8_STAGE(PG8_SA(0, 1), cA + hstep, voffA);
        if (wr == 1) PG8_BAR;
        PG8_WAIT_V(4); PG8_BAR;
        PG8_STAGE(PG8_SB(1, 0), cB + kstep, voffB); PG8_STAGE(PG8_SA(1, 0), cA + kstep, voffA); PG8_STAGE(PG8_SB(1, 1), cB + hstep + kstep, voffB);
        PG8_WAIT_V(6); PG8_BAR;
    }
    if constexpr (Epi::PRE) E.pre_finish(cur, lds, L0_);
    for (;;) {
        const bool has_next = S.next(ui + 1, nxt); nxt.par = (ui + 1) & 1;
        const char* nA = has_next ? (const char*)g.A + (size_t)nxt.pm * tstep : cA; const char* nB = has_next ? (const char*)g.Bt + (size_t)nxt.pn * tstep : cB;
        for (int t = 0; t < nt; t += 2) {
            if constexpr (Epi::MID) { static_assert(!FP8, "mid-loop accumulator hooks act on the bf16 path's accumulator array"); if (t == Epi::MID0) E.mid(acc, cur, 0, wr, wc); else if (t == Epi::MID1) E.mid(acc, cur, 1, wr, wc); }
            const bool last = (t == nt - 2);
            const char* a1 = cA + (size_t)(t + 1) * kstep;
            const char* a2 = last ? nA : cA + (size_t)(t + 2) * kstep; const char* b2 = last ? nB : cB + (size_t)(t + 2) * kstep;
            const char* a3 = a2 + kstep; const char* b3 = b2 + kstep;
            if (last && has_next) S.a_ready(nxt);
            if constexpr (SP2) {
            PG8_LDB(B0, 0, 0); PG8_LDB(B1, 0, 1); PG8_SCHED; PG8_LDA(At, 0, 0); PG8_STAGE(PG8_SA(1, 1), a1 + hstep, voffA);
            PG8_WAIT_V(8); PG8_WAIT_L(0); PG8_BAR; PG8_MMA(0, 0, At, B0); PG8_MMA(0, 1, At, B1); PG8_BAR; PG8_SCHED;
            PG8_LDA(At, 0, 1); PG8_STAGE(PG8_SB(0, 0), b2, voffB); PG8_STAGE(PG8_SB(0, 1), b2 + hstep, voffB); PG8_STAGE(PG8_SA(0, 0), a2, voffA);
            PG8_WAIT_V(8); PG8_WAIT_L(0); PG8_BAR; PG8_MMA(1, 0, At, B0); PG8_MMA(1, 1, At, B1); PG8_BAR; PG8_SCHED;
            PG8_LDB(B0, 1, 0); PG8_LDB(B1, 1, 1); PG8_SCHED; PG8_LDA(At, 1, 0); PG8_STAGE(PG8_SA(0, 1), a2 + hstep, voffA);
            PG8_WAIT_V(8); PG8_WAIT_L(0); PG8_BAR; PG8_MMA(0, 0, At, B0); PG8_MMA(0, 1, At, B1); PG8_BAR; PG8_SCHED;
            PG8_LDA(At, 1, 1); PG8_STAGE(PG8_SB(1, 0), b3, voffB); PG8_STAGE(PG8_SB(1, 1), b3 + hstep, voffB); PG8_STAGE(PG8_SA(1, 0), a3, voffA);
            PG8_WAIT_V(8); PG8_WAIT_L(0); PG8_BAR; PG8_MMA(1, 0, At, B0); PG8_MMA(1, 1, At, B1); PG8_BAR; PG8_SCHED;
            } else {
            PG8_LDB(B0, 0, 0); PG8_SCHED; PG8_LDA(At, 0, 0); PG8_STAGE(PG8_SA(1, 1), a1 + hstep, voffA);
            PG8_WAIT_L(8); PG8_BAR; PG8_WAIT_L(0); PG8_MMA(0, 0, At, B0); PG8_BAR; PG8_SCHED;
            PG8_LDB(B1, 0, 1); PG8_STAGE(PG8_SB(0, 0), b2, voffB);
            PG8_BAR; PG8_WAIT_L(0); PG8_MMA(0, 1, At, B1); PG8_BAR;
            PG8_LDA(At, 0, 1); PG8_STAGE(PG8_SA(0, 0), a2, voffA);
            PG8_BAR; PG8_WAIT_L(0); PG8_MMA(1, 0, At, B0); PG8_BAR; PG8_SCHED;
            PG8_STAGE(PG8_SB(0, 1), b2 + hstep, voffB);
            PG8_WAIT_V(6); PG8_BAR; PG8_MMA(1, 1, At, B1); PG8_BAR;
            PG8_LDB(B0, 1, 0); PG8_SCHED; PG8_LDA(At, 1, 0); PG8_STAGE(PG8_SA(0, 1), a2 + hstep, voffA);
            PG8_WAIT_L(8); PG8_BAR; PG8_WAIT_L(0); PG8_MMA(0, 0, At, B0); PG8_BAR; PG8_SCHED;
            PG8_LDB(B1, 1, 1); PG8_STAGE(PG8_SB(1, 0), b3, voffB);
            PG8_BAR; PG8_WAIT_L(0); PG8_MMA(0, 1, At, B1); PG8_BAR;
            PG8_LDA(At, 1, 1); PG8_STAGE(PG8_SA(1, 0), a3, voffA);
            PG8_BAR; PG8_WAIT_L(0); PG8_MMA(1, 0, At, B0); PG8_BAR; PG8_SCHED;
            PG8_STAGE(PG8_SB(1, 1), b3 + hstep, voffB);
            PG8_WAIT_V(6); PG8_BAR; PG8_MMA(1, 1, At, B1); PG8_BAR;
            }
        }
        if constexpr (ALIGN_EPI) { if (wr == 0) PG8_BAR; }
        if constexpr (FP8) { _Pragma("unroll") for (int a = 0; a < 2; ++a) _Pragma("unroll") for (int b = 0; b < 2; ++b) _Pragma("unroll") for (int m = 0; m < 4; ++m) _Pragma("unroll") for (int n = 0; n < 2; ++n) { const int o_ = (m * 2 + n) * 4;
            acc[a][b][m][n] = (f32x4){accq[a][b][o_], accq[a][b][o_ + 1], accq[a][b][o_ + 2], accq[a][b][o_ + 3]}; } }
        RstdLoads Lp_; if constexpr (Epi::PRE) { if (has_next) E.pre_issue(nxt, Lp_); }
        if constexpr (!Epi::AFTER_DRAIN) { E(acc, cur, wr, wc, fr, fq); S.done(cur); }
        if constexpr (Epi::PRE) { if (has_next) E.pre_finish(nxt, lds, Lp_); }
        if (!has_next) break;
#pragma unroll
        for (int a = 0; a < 2; ++a)
#pragma unroll
            for (int b = 0; b < 2; ++b)
#pragma unroll
                for (int m = 0; m < 4; ++m)
#pragma unroll
                    for (int n = 0; n < 2; ++n) { if constexpr (FP8) { _Pragma("unroll") for (int i_ = 0; i_ < 4; ++i_) accq[a][b][(m * 2 + n) * 4 + i_] = 0.f; } else acc[a][b][m][n] = (f32x4){0.f, 0.f, 0.f, 0.f}; }
        cur = nxt; cA = nA; cB = nB; ++ui;
        if constexpr (ALIGN_EPI) { if (wr == 1) PG8_BAR; }
    }
    PG8_WAIT_V(0);
    if constexpr (!ALIGN_EPI) { if (wr == 0) PG8_BAR; }
    PG8_BAR;
    if constexpr (Epi::AFTER_DRAIN) { E.fused(acc, cur, wr, wc, fr, fq, lds, wid, lane); S.done(cur); }
#undef PG8_SA
#undef PG8_SB
#undef PG8_STAGE
#undef PG8_LDA
#undef PG8_LDB
#undef PG8_LDP
#undef PG8_RA
#undef PG8_MMA
#undef PG8_WAIT_V
#undef PG8_WAIT_L
#undef PG8_BAR
#undef PG8_SCHED
}
}

#define GAS __attribute__((address_space(1)))
#define LAS __attribute__((address_space(3)))
typedef unsigned short bf16;
typedef unsigned v4u __attribute__((ext_vector_type(4)));
typedef float f32x4 __attribute__((ext_vector_type(4)));
typedef short bf16x8 __attribute__((ext_vector_type(8)));
typedef GAS unsigned gu32;
typedef GAS unsigned long long gu64;
#define RLX_AGENT __ATOMIC_RELAXED, __HIP_MEMORY_SCOPE_AGENT
#define LDS_WAIT() asm volatile("s_waitcnt lgkmcnt(0)" ::: "memory")
#define VM_WAIT() asm volatile("s_waitcnt vmcnt(0)" ::: "memory")
__device__ __forceinline__ unsigned long long rt() { return __builtin_amdgcn_s_memrealtime(); }
__device__ __forceinline__ unsigned f2bf(float f) { unsigned u = __builtin_bit_cast(unsigned, f); return (u + 0x7fffu + ((u >> 16) & 1u)) >> 16; }
__device__ __forceinline__ unsigned pk2(float lo, float hi) { return f2bf(lo) | (f2bf(hi) << 16); }

#define XB_TMO      128
#define XB_XCNT(j)  (256  + 64 * (j))
#define XB_XSUB(j)  (1280 + 64 * (j))
#define XB_XGEN(j)  (2304 + 64 * (j))
#define XB_TOP      3328
#define XB_TOPGEN   3392
#define XCD_BAR_WORDS 3456
#define XB_SPIN_CAP (1u << 18)

__device__ __forceinline__ unsigned xb_ld(unsigned* p)              { return __hip_atomic_load(p, __ATOMIC_RELAXED, __HIP_MEMORY_SCOPE_AGENT); }
__device__ __forceinline__ unsigned xb_add(unsigned* p, unsigned v) { return __hip_atomic_fetch_add(p, v, __ATOMIC_RELAXED, __HIP_MEMORY_SCOPE_AGENT); }
__device__ __forceinline__ unsigned xb_xcc_id() { return (unsigned)__builtin_amdgcn_s_getreg((3 << 11) | 20) & 0xFu; }
#define XB_SPIN(cond, bar) do { unsigned _sp = 0; while (cond) { __builtin_amdgcn_s_sleep(1); \
    if ((++_sp & 255u) == 0u) { if (xb_ld(&(bar)[XB_TMO])) break; if (_sp > XB_SPIN_CAP) { atomicAdd(&(bar)[XB_TMO], 1u); break; } } } } while (0)

struct XcdBarrier {
    unsigned* bar; unsigned x;
    volatile LAS unsigned* st;
};

__device__ __forceinline__ XcdBarrier xcd_barrier_post(unsigned* bar, volatile LAS unsigned* st) {
    XcdBarrier b; b.bar = bar; b.x = xb_xcc_id(); b.st = st;
    if (threadIdx.x == 0) (void)xb_add(&bar[XB_XCNT(b.x)], 1u);
    return b;
}
__device__ __forceinline__ void xcd_barrier_complete(unsigned* bar, unsigned x, unsigned& nloc, unsigned& nx) {
    const unsigned G = gridDim.x * gridDim.y * gridDim.z;
    unsigned sum, cnt, mine, sp = 0u;
    for (;;) {
        sum = 0u; cnt = 0u; mine = 0u;
#pragma unroll
        for (unsigned j = 0; j < 16; ++j) { const unsigned c = xb_ld(&bar[XB_XCNT(j)]); sum += c; cnt += (c > 0u) ? 1u : 0u; mine = (j == x) ? c : mine; }
        if (sum == G) break;
        __builtin_amdgcn_s_sleep(1);
        if ((++sp & 255u) == 0u) { if (xb_ld(&bar[XB_TMO])) break; if (sp > XB_SPIN_CAP) { atomicAdd(&bar[XB_TMO], 1u); break; } }
    }
    nloc = mine > 0u ? mine : 1u; nx = cnt > 0u ? cnt : 1u;
}

__device__ __forceinline__ void xcd_barrier(const XcdBarrier& b) {
    asm volatile("s_waitcnt vmcnt(0)" ::: "memory");
    __syncthreads();
    if (threadIdx.x == 0) {
        unsigned* bar = b.bar;
        __builtin_amdgcn_s_waitcnt(0);
        unsigned nloc = b.st[0], nx = b.st[1];
        if (nloc == 0u) { xcd_barrier_complete(bar, b.x, nloc, nx); b.st[0] = nloc; b.st[1] = nx; }
        const unsigned old = xb_add(&bar[XB_XSUB(b.x)], 1u);
        const unsigned gen = old / nloc;
        if (old + 1u == (gen + 1u) * nloc) {
            __builtin_amdgcn_fence(__ATOMIC_RELEASE, "agent");
            asm volatile("s_waitcnt vmcnt(0)" ::: "memory");
            const unsigned og = xb_add(&bar[XB_TOP], 1u);
            const unsigned tg = og / nx;
            if (og + 1u == (tg + 1u) * nx) xb_add(&bar[XB_TOPGEN], 1u);
            else XB_SPIN(xb_ld(&bar[XB_TOPGEN]) == tg, bar);
            __builtin_amdgcn_fence(__ATOMIC_ACQUIRE, "agent");
            xb_add(&bar[XB_XGEN(b.x)], 1u);
            asm volatile("s_waitcnt vmcnt(0)" ::: "memory");
        } else {
            XB_SPIN(xb_ld(&bar[XB_XGEN(b.x)]) == gen, bar);
            __builtin_amdgcn_fence(__ATOMIC_ACQUIRE, "agent");
            asm volatile("s_waitcnt vmcnt(0)" ::: "memory");
        }
    }
    __syncthreads();
}

constexpr int S_ = 8192, DM = 2048, FF = 5632, FF2 = 11264, NMIX = 17664, NMIXSRC = 17440, NADA = 18432;
constexpr int AH = 8, AW = 1024, NBLK = 32;
constexpr int SH = 32, SGRP = 4, XBCW = 3072, NCH = 32;
constexpr int CWID = 1024;
constexpr int MC_Q = 0, MC_K = 1024, MC_V = 2048, MC_Z = 3072, MC_XBC = 5120, MC_DT = 8192, MC_CB = 8448, MC_CC = 9472, MC_CX = 10496, MC_GA = 11520, MC_GS = 13568, MC_GC = 15616;
constexpr float LOG2E = 1.4426950408889634f;
constexpr float QSCALE = 0.08838834764831845f * 1.4426950408889634f;
constexpr float EPS = 1e-6f;

#ifndef STREAM_BF16
#define STREAM_BF16 1
#endif
#ifndef MIX_GATE_FP8
#define MIX_GATE_FP8 1
#endif
#ifndef LAST_FFN_FP8
#define LAST_FFN_FP8 1
#endif
constexpr size_t KiB = 1024, MiB = 1u << 20;
constexpr size_t WS_CTL = 0;
constexpr size_t WS_CNT = 64 * KiB;
constexpr int CNT_STRIDE = 32;
constexpr size_t ZERO_BYTES = 128 * KiB;
static_assert(WS_CNT + 2 * 8 * 32 * CNT_STRIDE * 4 <= ZERO_BYTES && (4096 + 3456) * 4 <= WS_CNT, "zero region");
constexpr size_t WS_ADA = 128 * KiB;
constexpr size_t WS_GK = WS_ADA + 2 * NADA * 4;
constexpr size_t WS_RSTD = WS_GK + 6 * 2048 * 4;
constexpr size_t WS_BIASIN = 352 * KiB;
constexpr size_t WS_BIASMIX = WS_BIASIN + 4 * FF2 * 4;
constexpr int BIAS_Q = 4; constexpr size_t BIAS_QS = 336 * KiB; constexpr int BIAS_QF = (int)(BIAS_QS / 4);
static_assert(WS_RSTD + S_ * 4 <= WS_BIASIN && WS_BIASMIX + 2 * NMIX * 4 <= WS_BIASIN + BIAS_QS && WS_BIASIN + BIAS_Q * BIAS_QS <= 2 * MiB, "bias partials");
static_assert(pg8::PG8_BIAS_QF == BIAS_QF, "epilogues and workspace map agree on the partial-bias stride");
static_assert(WS_RSTD + S_ * 4 <= 2 * MiB, "small vectors");
constexpr size_t WS_KMEAN = 2 * MiB;
constexpr size_t WS_LUT = WS_KMEAN + 8 * 32 * 128 * 4;
constexpr size_t WS_ACST = 3 * MiB;
constexpr size_t WS_ML = 4 * MiB;
constexpr size_t WS_LIST = 6 * MiB;
constexpr size_t WS_RSP = 14 * MiB;
constexpr size_t WS_GSP = 15 * MiB;
constexpr size_t WS_W = 16 * MiB;
constexpr size_t W_IN = 0, W_IN_SZ = (size_t)FF2 * DM * 2;
constexpr size_t W_OUT = W_IN + 2 * W_IN_SZ, W_OUT_SZ = (size_t)DM * FF * 2;
constexpr size_t W_MIX = W_OUT + 2 * W_OUT_SZ, W_MIX_SZ = (size_t)NMIX * DM * 2;
constexpr size_t W_BA = W_MIX + W_MIX_SZ, W_BS = W_BA + (size_t)DM * 1024 * 2, W_BC = W_BS + (size_t)DM * 2048 * 2, W_MO = W_BC + (size_t)DM * 1024 * 2;
constexpr size_t LAYER_W = W_MO + (size_t)DM * DM * 2;
constexpr size_t WS_XB = WS_W + 2 * LAYER_W;
constexpr size_t WS_XB8 = WS_XB + (size_t)S_ * DM * 2;
constexpr size_t WS_ACT = WS_XB8 + (size_t)S_ * DM;
constexpr size_t A_HID = WS_ACT;
constexpr size_t A_MIX = WS_ACT;
constexpr size_t A_QN = A_MIX + (size_t)S_ * NMIX * 2;
constexpr size_t A_KN = A_QN + (size_t)S_ * AW * 2;
constexpr size_t A_XC = A_KN + (size_t)S_ * AW * 2;
constexpr size_t A_XDT = A_XC + (size_t)S_ * XBCW * 2;
constexpr size_t A_BT = A_XDT + (size_t)2048 * S_ * 2;
constexpr size_t A_STATES = A_BT + (size_t)512 * S_ * 2;
constexpr size_t A_PREV = A_STATES + (size_t)NCH * SH * 64 * 128 * 4;
constexpr size_t A_CBM = A_PREV + (size_t)NCH * SH * 64 * 128 * 2;
constexpr size_t A_YCAT = A_CBM + (size_t)NCH * SGRP * 256 * 256 * 2;
constexpr int YCAT_LD = 4096, YC_ATTN = 0, YC_SSD = 1024, YC_CONV = 3072;
constexpr size_t A_PART = A_YCAT + (size_t)S_ * YCAT_LD * 2;
constexpr size_t WS_END = A_PART + (size_t)4 * S_ * AW * 2;
constexpr size_t A_MRG = A_XDT;
static_assert(A_MRG + (size_t)S_ * DM * 2 <= A_BT, "overlays");
static_assert(WS_END <= (size_t)1200 * MiB, "workspace map must stay under the guaranteed scratch size");
static_assert(A_HID + (size_t)S_ * FF * 2 <= A_QN, "HID overlays MIX only");
constexpr int CW_BAR = 4096;

constexpr int RING_BYTES = 131072;
constexpr int SCR_OFF = RING_BYTES, SCR_BYTES = 24576;
constexpr int MISC_OFF = SCR_OFF + SCR_BYTES;
constexpr int LDS_BYTES = 156672;
static_assert(MISC_OFF + 256 <= LDS_BYTES, "LDS map");
constexpr int NWAVES = 8;


typedef float f32x16 __attribute__((ext_vector_type(16)));
typedef float f32x2 __attribute__((ext_vector_type(2)));
typedef short s16x4 __attribute__((ext_vector_type(4)));
struct Ctx {
    unsigned char* lds;
    int tid, lane, wave, G, bid;
    const float* in[21];
    float* out; unsigned char* ws;
};
enum { IN_X = 0, IN_C, IN_WADA, IN_BADA, IN_GAIN, IN_WFFIN, IN_WFFOUT, IN_WMIX, IN_QKN, IN_RELB, IN_WSCONV, IN_BSCONV, IN_DTB, IN_ALOG, IN_SSDD, IN_SSDN, IN_WSC, IN_WBA, IN_WBS, IN_WBC, IN_WMO };

__device__ __forceinline__ float wave_sum(float v) {
#pragma unroll
    for (int o = 1; o < 64; o <<= 1) v += __shfl_xor(v, o);
    return v;
}
__device__ __forceinline__ float bf2f(bf16 b) { return __uint_as_float((unsigned)b << 16); }
__device__ __forceinline__ unsigned cvtpk(float lo, float hi) { unsigned r; asm volatile("v_cvt_pk_bf16_f32 %0, %1, %2" : "=v"(r) : "v"(lo), "v"(hi)); return r; }
#define UNPACK8(V_, f) do { const v4u u8_ = (V_); f[0] = __uint_as_float(u8_.x << 16); f[1] = __uint_as_float(u8_.x & 0xffff0000u); f[2] = __uint_as_float(u8_.y << 16); f[3] = __uint_as_float(u8_.y & 0xffff0000u); \
                           f[4] = __uint_as_float(u8_.z << 16); f[5] = __uint_as_float(u8_.z & 0xffff0000u); f[6] = __uint_as_float(u8_.w << 16); f[7] = __uint_as_float(u8_.w & 0xffff0000u); } while (0)
#define PACK8(f) ((v4u){cvtpk(f[0], f[1]), cvtpk(f[2], f[3]), cvtpk(f[4], f[5]), cvtpk(f[6], f[7])})
__device__ __forceinline__ int crow(int r, int hi) { return (r & 3) + 8 * (r >> 2) + 4 * hi; }
__device__ __forceinline__ float silu_f(float v) { return v * __builtin_amdgcn_rcpf(1.0f + __expf(-v)); }

__device__ __forceinline__ void ph_ada(const Ctx& C) {
    const float* cvec = C.in[IN_C]; const float* W = C.in[IN_WADA]; const float* b = C.in[IN_BADA];
    float* ada = (float*)(C.ws + WS_ADA); f32x4* red = (f32x4*)C.lds;
    for (int it = C.bid; it < 256; it += C.G) {
        const int l = it >> 7, j = (it & 127) * 144 + C.lane * 4, k0 = C.wave * 256;
        f32x4 acc = (f32x4){0.f, 0.f, 0.f, 0.f};
        if (C.lane < 36) { const float* Wp = W + ((size_t)l * 2048 + k0) * NADA + j;
#pragma unroll 16
            for (int kk = 0; kk < 256; ++kk) { const float cv = cvec[k0 + kk]; const float s = silu_f(cv); const f32x4 w = *(const f32x4*)(Wp + (size_t)kk * NADA); acc = acc + w * s; }
            red[C.wave * 36 + C.lane] = acc; }
        __syncthreads();
        if (C.tid < 36) { f32x4 t = *(const f32x4*)(b + l * NADA + j);
#pragma unroll
            for (int w = 0; w < 8; ++w) t = t + red[w * 36 + C.tid];
            *(f32x4*)(ada + l * NADA + j) = t;
            const int jj = (it & 127) * 144 + C.tid * 4, sub = jj / 6144, kind = (jj / 2048) % 3, d = jj & 2047;
            if (kind == 1) { const f32x4 g = *(const f32x4*)(C.in[IN_GAIN] + (l * 3 + sub) * 2048 + d); *(f32x4*)((float*)(C.ws + WS_GK) + (l * 3 + sub) * 2048 + d) = g * (t + 1.0f); } }
        __syncthreads();
    }
}

template <bool F8> __device__ __forceinline__ void tr_item(const float* W, int K, int N, int kb0, int nkb, int n0, bf16* WT, int drow0, const float* gk, const float* sh, float* bias, LAS float* scr, int lane, int dpitch = 0, int dk0 = 0) {
    if (dpitch == 0) dpitch = K;
    const int kr = lane >> 3, nc = (lane & 7) * 4;
    const float* Wp = W + (size_t)(64 * kb0 + kr) * N + n0 + nc;
    f32x4 bacc = (f32x4){0.f, 0.f, 0.f, 0.f};
    f32x4 cur[8], nx1[8];
#pragma unroll
    for (int i = 0; i < 8; ++i) cur[i] = *(const f32x4*)(Wp + (size_t)(8 * i) * N);
#pragma unroll
    for (int i = 0; i < 8; ++i) nx1[i] = nkb > 1 ? *(const f32x4*)(Wp + (size_t)(64 + 8 * i) * N) : cur[i];
    for (int kb = kb0; kb < kb0 + nkb; ++kb) { const int k0 = 64 * kb;
        f32x4 nx2[8];
        if (kb + 2 < kb0 + nkb) {
#pragma unroll
            for (int i = 0; i < 8; ++i) nx2[i] = *(const f32x4*)(Wp + (size_t)(64 * (kb + 2 - kb0) + 8 * i) * N); }
        else {
#pragma unroll
            for (int i = 0; i < 8; ++i) nx2[i] = cur[i]; }
#pragma unroll
        for (int i = 0; i < 8; ++i) { const int kk = 8 * i + kr, k = k0 + kk; f32x4 v = cur[i];
            if (sh) bacc = bacc + v * sh[k];
            if (gk) v = v * gk[k];
            LAS float* d = scr + kk * 33 + nc; d[0] = v[0]; d[1] = v[1]; d[2] = v[2]; d[3] = v[3]; }
        LDS_WAIT(); asm volatile("" ::: "memory");
        const int c = lane & 7;
#pragma unroll
        for (int j = 0; j < 4; ++j) { const int n = (lane >> 3) + 8 * j; const LAS float* s = scr + (8 * c) * 33 + n;
            if constexpr (F8) { pg8::u32x2 o; o.x = pg8::pk4_fp8(s[0 * 33] * pg8::WS8, s[1 * 33] * pg8::WS8, s[2 * 33] * pg8::WS8, s[3 * 33] * pg8::WS8); o.y = pg8::pk4_fp8(s[4 * 33] * pg8::WS8, s[5 * 33] * pg8::WS8, s[6 * 33] * pg8::WS8, s[7 * 33] * pg8::WS8);
                *(GAS pg8::u32x2*)((unsigned char*)WT + (size_t)(drow0 + n) * dpitch + dk0 + k0 + 8 * c) = o; }
            else { v4u o; o.x = pk2(s[0 * 33], s[1 * 33]); o.y = pk2(s[2 * 33], s[3 * 33]); o.z = pk2(s[4 * 33], s[5 * 33]); o.w = pk2(s[6 * 33], s[7 * 33]);
                *(GAS v4u*)(WT + (size_t)(drow0 + n) * dpitch + dk0 + k0 + 8 * c) = o; } }
        LDS_WAIT(); asm volatile("" ::: "memory");
#pragma unroll
        for (int i = 0; i < 8; ++i) { cur[i] = nx1[i]; nx1[i] = nx2[i]; } }
    if (sh) {
#pragma unroll
        for (int e = 0; e < 4; ++e) { float b = bacc[e]; b += __shfl_xor(b, 8); b += __shfl_xor(b, 16); b += __shfl_xor(b, 32); bacc[e] = b; }
        if (lane < 8) *(f32x4*)(bias + drow0 + nc) = bacc; }
}
__device__ __forceinline__ void ph_convert(const Ctx& C) {
    LAS float* scr = (LAS float*)((LAS unsigned char*)C.lds + C.wave * 16384);
    const int gw = C.bid * NWAVES + C.wave, NGW = C.G * NWAVES;
    const float* ada = (const float*)(C.ws + WS_ADA);
    constexpr int I_IN = FF2 / 32, I_MIX = NMIXSRC / 32;
    constexpr int I_LAYER = 2 * I_IN + I_MIX;
    for (int it4 = gw; it4 < BIAS_Q * 2 * I_LAYER; it4 += NGW) {
        const int it = it4 >> 2, kq = it4 & 3, kb0 = 8 * kq; const int bq = kq * BIAS_QF;
        const int l = it / I_LAYER; int r = it - l * I_LAYER;
        unsigned char* wl = C.ws + WS_W + (size_t)l * LAYER_W;
        const float* adal = ada + l * NADA; const float* gkl = (const float*)(C.ws + WS_GK) + l * 3 * 2048;
        if (r < 2 * I_IN) { const int f = r / I_IN; r -= f * I_IN; const int sub = f * 2;
            const int n0 = 32 * r;
            const int bj = n0 / FF, j = n0 - bj * FF, drow0 = (j / 128) * 256 + bj * 128 + (j % 128);
            if (LAST_FFN_FP8 && l == 1 && f == 1) tr_item<true>(C.in[IN_WFFIN] + (size_t)(l * 2 + f) * DM * FF2, DM, FF2, kb0, 8, n0, (bf16*)(wl + W_IN + f * W_IN_SZ), drow0,
                    gkl + sub * 2048, adal + (sub * 3 + 0) * 2048, (float*)(C.ws + WS_BIASIN) + bq + (l * 2 + f) * FF2, scr, C.lane);
            else tr_item<false>(C.in[IN_WFFIN] + (size_t)(l * 2 + f) * DM * FF2, DM, FF2, kb0, 8, n0, (bf16*)(wl + W_IN + f * W_IN_SZ), drow0,
                    gkl + sub * 2048, adal + (sub * 3 + 0) * 2048, (float*)(C.ws + WS_BIASIN) + bq + (l * 2 + f) * FF2, scr, C.lane);
            continue; }
        r -= 2 * I_IN;
        if (r < I_MIX) { const int n0 = 32 * r; const int drow0 = n0 < 8224 ? n0 : n0 + 224;
            if (MIX_GATE_FP8 && l == 1 && drow0 >= MC_GA) { tr_item<true>(C.in[IN_WMIX] + (size_t)l * DM * NMIXSRC, DM, NMIXSRC, kb0, 8, n0, (bf16*)(wl + W_MIX + (size_t)MC_GA * DM * 2), drow0 - MC_GA,
                    gkl + 1 * 2048, adal + (1 * 3 + 0) * 2048, (float*)(C.ws + WS_BIASMIX) + bq + l * NMIX + MC_GA, scr, C.lane); continue; }
            tr_item<false>(C.in[IN_WMIX] + (size_t)l * DM * NMIXSRC, DM, NMIXSRC, kb0, 8, n0, (bf16*)(wl + W_MIX), drow0,
                    gkl + 1 * 2048, adal + (1 * 3 + 0) * 2048, (float*)(C.ws + WS_BIASMIX) + bq + l * NMIX, scr, C.lane);
            continue; }
    }
    for (int it = gw; it < 2 * 224; it += NGW) { const int l = it / 224, row = 8224 + it % 224; GAS v4u* p = (GAS v4u*)(C.ws + WS_W + (size_t)l * LAYER_W + W_MIX + (size_t)row * DM * 2);
#pragma unroll
        for (int j = 0; j < 4; ++j) p[C.lane + 64 * j] = (v4u){0u, 0u, 0u, 0u};
        if (C.lane < BIAS_Q) ((float*)(C.ws + WS_BIASMIX))[C.lane * BIAS_QF + l * NMIX + row] = 0.f; }
    { const float* x = C.in[IN_X]; unsigned char* XB8 = C.ws + WS_XB8; float* rsp = (float*)(C.ws + WS_RSP);
      for (int m = gw; m < S_; m += NGW) { const GAS f32x4* xr = (const GAS f32x4*)(x + (size_t)m * DM) + C.lane; float ss = 0.f;
          GAS unsigned* o4 = (GAS unsigned*)((unsigned char*)XB8 + (size_t)m * DM) + C.lane; GAS unsigned long long* o8 = (GAS unsigned long long*)((bf16*)(C.ws + WS_XB) + (size_t)m * DM) + C.lane;
#pragma unroll
          for (int j = 0; j < 8; ++j) { const f32x4 v = xr[64 * j]; ss += (v.x * v.x + v.y * v.y) + (v.z * v.z + v.w * v.w);
              (void)o4; o8[64 * j] = (unsigned long long)pk2(v.x, v.y) | ((unsigned long long)pk2(v.z, v.w) << 32); }
          ss = wave_sum(ss); if (C.lane < 32) rsp[(size_t)m * 32 + C.lane] = C.lane == 0 ? ss : 0.f; } }
    if (C.bid == 0) { float* lut = (float*)(C.ws + WS_LUT); const float* rb = C.in[IN_RELB];
        for (int i = C.tid; i < 8 * 129; i += NWAVES * 64) { const int h = i / 129, d = i % 129; int bk;
            if (d < 16) bk = d; else { const float ratio = logf((float)d / 16.0f) / 2.0794415416798357f; bk = 16 + (int)(ratio * 16.0f); if (bk > 31) bk = 31; }
            lut[h * 132 + d] = rb[bk * 8 + h] * LOG2E; } }
}


__device__ __forceinline__ void convert_tail(const Ctx& C, int l, int what, int iw, int niw) {
    LAS float* scr = (LAS float*)((LAS unsigned char*)C.lds + C.wave * 16384);
    unsigned char* wl = C.ws + WS_W + (size_t)l * LAYER_W;
    if (what != 1) { const int f = what >> 1;
        for (int it = iw; it < 22 * 64; it += niw) { const int kr = it >> 6, n0 = 32 * (it & 63);
            if (LAST_FFN_FP8 && l == 1 && f == 1) tr_item<true>(C.in[IN_WFFOUT] + (size_t)(l * 2 + f) * FF * DM, FF, DM, 4 * kr, 4, n0, (bf16*)(wl + W_OUT + f * W_OUT_SZ), n0, nullptr, nullptr, nullptr, scr, C.lane);
            else tr_item<false>(C.in[IN_WFFOUT] + (size_t)(l * 2 + f) * FF * DM, FF, DM, 4 * kr, 4, n0, (bf16*)(wl + W_OUT + f * W_OUT_SZ), n0, nullptr, nullptr, nullptr, scr, C.lane); }
        return; }
    for (int it = iw; it < 1536; it += niw) {
        if (it < 256) { const int kr = it >> 6, n0 = 32 * (it & 63); tr_item<false>(C.in[IN_WBA] + (size_t)l * 1024 * DM, 1024, DM, 4 * kr, 4, n0, (bf16*)(wl + W_BA), n0, nullptr, nullptr, nullptr, scr, C.lane, YCAT_LD, YC_ATTN); }
        else if (it < 768) { const int r = it - 256, kr = r >> 6, n0 = 32 * (r & 63);
            tr_item<false>(C.in[IN_WBS] + (size_t)l * 2048 * DM, 2048, DM, 4 * kr, 4, n0, (bf16*)(wl + W_BA), n0, C.in[IN_SSDN] + l * 2048, nullptr, nullptr, scr, C.lane, YCAT_LD, YC_SSD); }
        else if (it < 1024) { const int r = it - 768, kr = r >> 6, n0 = 32 * (r & 63); tr_item<false>(C.in[IN_WBC] + (size_t)l * 1024 * DM, 1024, DM, 4 * kr, 4, n0, (bf16*)(wl + W_BA), n0, nullptr, nullptr, nullptr, scr, C.lane, YCAT_LD, YC_CONV); }
        else { const int r = it - 1024, kr = r >> 6, n0 = 32 * (r & 63); tr_item<false>(C.in[IN_WMO] + (size_t)l * DM * DM, DM, DM, 4 * kr, 4, n0, (bf16*)(wl + W_MO), n0, nullptr, nullptr, nullptr, scr, C.lane); }
    }
}
__device__ __forceinline__ void tail_waves(const Ctx& C, int nunits, int& iw, int& niw) {
    const int rounds = (nunits + C.G - 1) / C.G, cut = nunits - (rounds - 1) * C.G;
    if (cut >= C.G) { iw = C.bid * NWAVES + C.wave; niw = C.G * NWAVES; }
    else if (C.bid >= cut) { iw = (C.bid - cut) * NWAVES + C.wave; niw = (C.G - cut) * NWAVES; }
    else { iw = 0; niw = 0; }
}

#define PREP_BAR() do { asm volatile("s_waitcnt lgkmcnt(0)" ::: "memory"); __builtin_amdgcn_s_barrier(); asm volatile("" ::: "memory"); } while (0)
__device__ __forceinline__ void prep_qk_load(const Ctx& C, int u, v4u (&wq)[8]) {
    const int c = u >> 4, h = (u >> 1) & 7, which = u & 1; const bf16* MIX = (const bf16*)(C.ws + A_MIX); const int l16 = C.tid & 15, rsub = C.tid >> 4;
#pragma unroll
    for (int ps = 0; ps < 8; ++ps) wq[ps] = *(const v4u*)(MIX + (size_t)(256 * c + ps * 32 + rsub) * NMIX + which * 1024 + h * 128 + l16 * 8);
}
__device__ __forceinline__ void prep_qk_unit(const Ctx& C, int l, int u, const v4u (&wq)[8], bool hn, int un, v4u (&nq)[8]) {
    const int c = u >> 4, h = (u >> 1) & 7, which = u & 1;
    bf16* dst = (bf16*)(C.ws + (which ? A_KN : A_QN));
    const float* gn = C.in[IN_QKN] + (l * 2 + which) * 128;
    const int l16 = C.tid & 15, rsub = C.tid >> 4;
    float g[8];
#pragma unroll
    for (int e = 0; e < 8; ++e) g[e] = gn[l16 * 8 + e] * (which ? 1.0f : QSCALE);
    if (hn) prep_qk_load(C, un, nq);
    float cs[8];
#pragma unroll
    for (int e = 0; e < 8; ++e) cs[e] = 0.f;
#pragma unroll
    for (int ps = 0; ps < 8; ++ps) { const int r = 256 * c + ps * 32 + rsub;
        const v4u w = wq[ps];
        float f[8]; UNPACK8(w, f); float ss = 0.f;
#pragma unroll
        for (int e = 0; e < 8; ++e) ss += f[e] * f[e];
        ss += __shfl_xor(ss, 1); ss += __shfl_xor(ss, 2); ss += __shfl_xor(ss, 4); ss += __shfl_xor(ss, 8);
        const float rs = rsqrtf(ss * (1.0f / 128.0f) + EPS);
#pragma unroll
        for (int e = 0; e < 8; ++e) { f[e] = f[e] * rs * g[e]; cs[e] += f[e]; }
        *(v4u*)(dst + (size_t)r * AW + h * 128 + l16 * 8) = PACK8(f); }
    if (which) {
        float* scr = (float*)(C.lds);
#pragma unroll
        for (int e = 0; e < 8; ++e) { cs[e] += __shfl_xor(cs[e], 16); cs[e] += __shfl_xor(cs[e], 32); }
        if (C.lane < 16) {
#pragma unroll
            for (int e = 0; e < 8; ++e) scr[C.wave * 128 + l16 * 8 + e] = cs[e]; }
        PREP_BAR();
        if (C.tid < 128) { float s = 0.f;
#pragma unroll
            for (int w = 0; w < 8; ++w) s += scr[w * 128 + C.tid];
            ((float*)(C.ws + WS_KMEAN))[(h * 32 + c) * 128 + C.tid] = s * (1.0f / 256.0f); }
        PREP_BAR();
    }
}
__device__ __forceinline__ void prep_ssd_load(const Ctx& C, int u, v4u (&rawq)[7], float& dtraw) {
    const int c = u / 48, s = u % 48, ch0 = 64 * s; const bf16* MIX = (const bf16*)(C.ws + A_MIX); const int cg = C.tid & 7, rg = C.tid >> 3;
#pragma unroll
    for (int i = 0; i < 7; ++i) { const int t = 256 * c + 4 * rg - 3 + i; rawq[i] = t >= 0 ? *(const v4u*)(MIX + (size_t)t * NMIX + MC_XBC + ch0 + cg * 8) : (v4u){0u, 0u, 0u, 0u}; }
    dtraw = (s < 32 && C.tid < 256) ? bf2f(MIX[(size_t)(256 * c + C.tid) * NMIX + MC_DT + s]) : 0.f;
}
__device__ __forceinline__ void prep_ssd_unit(const Ctx& C, int l, int u, const v4u (&rawq)[7], float dtraw, bool hn, int un, v4u (&nq)[7], float& ndt) {
    const int c = u / 48, s = u % 48, ch0 = 64 * s;
    bf16* XC = (bf16*)(C.ws + A_XC);
    float* dtL = (float*)(C.lds); float* adL = dtL + 256;
    bf16* T = (bf16*)(C.lds + 4096);
    const int cg = C.tid & 7, rg = C.tid >> 3;
    const float* wc = C.in[IN_WSCONV] + (size_t)l * 4 * XBCW + ch0 + cg * 8; const float* bc = C.in[IN_BSCONV] + (size_t)l * XBCW + ch0 + cg * 8;
    float wv[4][8], bv[8];
#pragma unroll
    for (int j = 0; j < 4; ++j) { const f32x4 a = *(const f32x4*)(wc + j * XBCW), b = *(const f32x4*)(wc + j * XBCW + 4);
        wv[j][0] = a[0]; wv[j][1] = a[1]; wv[j][2] = a[2]; wv[j][3] = a[3]; wv[j][4] = b[0]; wv[j][5] = b[1]; wv[j][6] = b[2]; wv[j][7] = b[3]; }
    { const f32x4 a = *(const f32x4*)bc, b = *(const f32x4*)(bc + 4); bv[0] = a[0]; bv[1] = a[1]; bv[2] = a[2]; bv[3] = a[3]; bv[4] = b[0]; bv[5] = b[1]; bv[6] = b[2]; bv[7] = b[3]; }
    const float alog_ = C.in[IN_ALOG][l * 32 + (s & 31)], dtb_ = C.in[IN_DTB][l * 32 + (s & 31)];
    if (hn) prep_ssd_load(C, un, nq, ndt);
    if (s < 32) {
        if (C.tid < 256) { const float a = -__expf(alog_);
            const float raw = dtraw + dtb_;
            const float ex = __expf(raw); const float dt = raw > 20.f ? raw : (ex < 1e-3f ? ex * (1.0f - ex * (0.5f - ex * (1.0f / 3.0f))) : __logf(1.0f + ex));
            dtL[C.tid] = dt; adL[C.tid] = dt * a; }
        PREP_BAR();
        if (C.wave == 0) {
            float v0 = adL[4 * C.lane], v1 = adL[4 * C.lane + 1], v2 = adL[4 * C.lane + 2], v3 = adL[4 * C.lane + 3];
            v1 += v0; v2 += v1; v3 += v2; float tot = v3;
#pragma unroll
            for (int o = 1; o < 64; o <<= 1) { const float t = __shfl_up(tot, o); if (C.lane >= o) tot += t; }
            const float base = tot - v3;
            float* ac = (float*)(C.ws + WS_ACST) + (size_t)s * S_ + 256 * c + 4 * C.lane;
            *(f32x4*)ac = (f32x4){base + v0, base + v1, base + v2, base + v3}; }
    }
    float raw[7][8];
#pragma unroll
    for (int i = 0; i < 7; ++i) { UNPACK8(rawq[i], raw[i]); }
#pragma unroll
    for (int i = 0; i < 4; ++i) { float o[8]; const int rl = 4 * rg + i;
#pragma unroll
        for (int e = 0; e < 8; ++e) { float v = bv[e];
#pragma unroll
            for (int j = 0; j < 4; ++j) v += wv[j][e] * raw[i + j][e];
            o[e] = silu_f(v); }
        *(v4u*)(XC + (size_t)(256 * c + rl) * XBCW + ch0 + cg * 8) = PACK8(o);
        if (s < 40) { const float sc = s < 32 ? dtL[rl] : 1.0f;
#pragma unroll
            for (int e = 0; e < 8; ++e) T[(cg * 8 + e) * 264 + rl] = (bf16)f2bf(o[e] * sc); } }
    if (s < 40) {
        PREP_BAR();
        bf16* dstT = s < 32 ? (bf16*)(C.ws + A_XDT) + (size_t)(64 * s) * S_ : (bf16*)(C.ws + A_BT) + (size_t)(64 * (s - 32)) * S_;
        const int ch = C.tid >> 3;
#pragma unroll
        for (int jj = 0; jj < 4; ++jj) { const int chunk = (C.tid & 7) + 8 * jj;
            const v4u w = *(const v4u*)(T + ch * 264 + chunk * 8);
            *(v4u*)(dstT + (size_t)ch * S_ + 256 * c + chunk * 8) = w; }
    }
    PREP_BAR();
}
__device__ __forceinline__ void prep_conv_load(const Ctx& C, int u, v4u (&aq)[6], v4u (&bq)[6], v4u (&gq)[4]) {
    const int c = u >> 4, s = u & 15, ch0 = 64 * s, cg = C.tid & 7, rg = C.tid >> 3; const bf16* MIX = (const bf16*)(C.ws + A_MIX);
#pragma unroll
    for (int i = 0; i < 6; ++i) { const int t = 256 * c + 4 * rg - 2 + i;
        aq[i] = t >= 0 ? *(const v4u*)(MIX + (size_t)t * NMIX + MC_CC + ch0 + cg * 8) : (v4u){0u, 0u, 0u, 0u}; bq[i] = t >= 0 ? *(const v4u*)(MIX + (size_t)t * NMIX + MC_CX + ch0 + cg * 8) : (v4u){0u, 0u, 0u, 0u}; }
#pragma unroll
    for (int i = 0; i < 4; ++i) gq[i] = *(const v4u*)(MIX + (size_t)(256 * c + 4 * rg + i) * NMIX + MC_CB + ch0 + cg * 8);
}
__device__ __forceinline__ void prep_conv_unit(const Ctx& C, int l, int u, const v4u (&aq)[6], const v4u (&bq)[6], const v4u (&gq)[4]) {
    const int c = u >> 4, s = u & 15, ch0 = 64 * s, cg = C.tid & 7, rg = C.tid >> 3;
    bf16* Y = (bf16*)(C.ws + A_YCAT) + YC_CONV;
    const float* wc = C.in[IN_WSC] + (size_t)l * 3 * CWID + ch0 + cg * 8;
    float wv[3][8];
#pragma unroll
    for (int j = 0; j < 3; ++j) { const f32x4 a = *(const f32x4*)(wc + j * CWID), b = *(const f32x4*)(wc + j * CWID + 4);
        wv[j][0] = a[0]; wv[j][1] = a[1]; wv[j][2] = a[2]; wv[j][3] = a[3]; wv[j][4] = b[0]; wv[j][5] = b[1]; wv[j][6] = b[2]; wv[j][7] = b[3]; }
    float pr[6][8];
#pragma unroll
    for (int i = 0; i < 6; ++i) { float fa[8], fb[8]; UNPACK8(aq[i], fa); UNPACK8(bq[i], fb);
#pragma unroll
        for (int e = 0; e < 8; ++e) pr[i][e] = fa[e] * fb[e]; }
#pragma unroll
    for (int i = 0; i < 4; ++i) { const int t = 256 * c + 4 * rg + i;
        const v4u g = gq[i]; float fg[8], o[8]; UNPACK8(g, fg);
#pragma unroll
        for (int e = 0; e < 8; ++e) o[e] = fg[e] * (wv[0][e] * pr[i][e] + wv[1][e] * pr[i + 1][e] + wv[2][e] * pr[i + 2][e]);
        *(v4u*)(Y + (size_t)t * YCAT_LD + ch0 + cg * 8) = PACK8(o); }
}
__device__ __forceinline__ void ph_prep_qk(const Ctx& C, int l) {
    int u = C.bid; v4u cur[8], nxt[8];
    if (u < 512) prep_qk_load(C, u, cur);
    for (; u < 512; u += C.G) { const bool hn = u + C.G < 512; prep_qk_unit(C, l, u, cur, hn, u + C.G, nxt);
        if (hn) {
#pragma unroll
            for (int i = 0; i < 8; ++i) cur[i] = nxt[i]; } }
}
__device__ __forceinline__ void ph_prep_ssd(const Ctx& C, int l) {
    int u = (512 / C.G) * C.G + C.bid; if (u < 512) u += C.G; u -= 512;
    v4u cur[7], nxt[7]; float cdt = 0.f, ndt = 0.f;
    if (u < 1536) prep_ssd_load(C, u, cur, cdt);
    for (; u < 1536; u += C.G) { const bool hn = u + C.G < 1536; prep_ssd_unit(C, l, u, cur, cdt, hn, u + C.G, nxt, ndt);
        if (hn) { cdt = ndt;
#pragma unroll
            for (int i = 0; i < 7; ++i) cur[i] = nxt[i]; } }
}
__device__ __forceinline__ void ph_prep_conv(const Ctx& C, int l) {
    int u = (2048 / C.G) * C.G + C.bid; if (u < 2048) u += C.G; u -= 2048;
    for (; u < 512; u += C.G) { v4u ca[6], cb[6], cg[4]; prep_conv_load(C, u, ca, cb, cg); prep_conv_unit(C, l, u, ca, cb, cg); }
}

#define MFMA32(a, b, c) __builtin_amdgcn_mfma_f32_32x32x16_bf16(__builtin_bit_cast(bf16x8, a), __builtin_bit_cast(bf16x8, b), c, 0, 0, 0)
#define TK_BETTER(v, j, bv, bj) ((v) > (bv) || ((v) == (bv) && (j) < (bj)))
#define TK_INSERT(v, j) do { if (TK_BETTER(v, j, b0, j0)) { b2 = b1; j2 = j1; b1 = b0; j1 = j0; b0 = (v); j0 = (j); } \
                             else if (TK_BETTER(v, j, b1, j1)) { b2 = b1; j2 = j1; b1 = (v); j1 = (j); } \
                             else if (TK_BETTER(v, j, b2, j2)) { b2 = (v); j2 = (j); } } while (0)
__device__ __forceinline__ void select_unit(const Ctx& C, int l, int u) {
    const int h = u >> 5, qb = u & 31;
    if (qb == 0) return;
    const int r32 = C.lane & 31, hi = C.lane >> 5, q = 256 * qb + 32 * C.wave + r32;
    LAS unsigned* hist = (LAS unsigned*)((LAS unsigned char*)C.lds); LAS unsigned* basev = hist + 32;
    if (C.tid < 32) hist[C.tid] = 0u;
    const bf16* qp = (const bf16*)(C.ws + A_QN) + (size_t)q * AW + h * 128 + 8 * hi;
    const float* kp = (const float*)(C.ws + WS_KMEAN) + ((size_t)h * 32 + r32) * 128 + 8 * hi;
    f32x16 acc = {};
    v4u qv[8]; f32x4 kv0[8], kv1[8];
#pragma unroll
    for (int ks = 0; ks < 8; ++ks) { qv[ks] = *(const v4u*)(qp + 16 * ks); kv0[ks] = *(const f32x4*)(kp + 16 * ks); kv1[ks] = *(const f32x4*)(kp + 16 * ks + 4); }
#pragma unroll
    for (int ks = 0; ks < 8; ++ks) { const v4u b = qv[ks];
        const f32x4 k0 = kv0[ks], k1 = kv1[ks];
        float kh[8], kl[8];
        kh[0] = __uint_as_float(f2bf(k0[0]) << 16); kh[1] = __uint_as_float(f2bf(k0[1]) << 16); kh[2] = __uint_as_float(f2bf(k0[2]) << 16); kh[3] = __uint_as_float(f2bf(k0[3]) << 16);
        kh[4] = __uint_as_float(f2bf(k1[0]) << 16); kh[5] = __uint_as_float(f2bf(k1[1]) << 16); kh[6] = __uint_as_float(f2bf(k1[2]) << 16); kh[7] = __uint_as_float(f2bf(k1[3]) << 16);
        kl[0] = k0[0] - kh[0]; kl[1] = k0[1] - kh[1]; kl[2] = k0[2] - kh[2]; kl[3] = k0[3] - kh[3]; kl[4] = k1[0] - kh[4]; kl[5] = k1[1] - kh[5]; kl[6] = k1[2] - kh[6]; kl[7] = k1[3] - kh[7];
        const v4u ah = PACK8(kh), al = PACK8(kl);
        acc = MFMA32(ah, b, acc); acc = MFMA32(al, b, acc); }
    int j0 = 64, j1 = 64, j2 = 64; float b0 = -INFINITY, b1 = -INFINITY, b2 = -INFINITY;
#pragma unroll
    for (int r = 0; r < 16; ++r) { const int j = crow(r, hi); if (j < qb) { const float v = acc[r]; TK_INSERT(v, j); } }
    { const auto s0_ = __builtin_amdgcn_permlane32_swap(__float_as_uint(b0), __float_as_uint(b0), false, false); const auto t0_ = __builtin_amdgcn_permlane32_swap((unsigned)j0, (unsigned)j0, false, false);
      const auto s1_ = __builtin_amdgcn_permlane32_swap(__float_as_uint(b1), __float_as_uint(b1), false, false); const auto t1_ = __builtin_amdgcn_permlane32_swap((unsigned)j1, (unsigned)j1, false, false);
      const auto s2_ = __builtin_amdgcn_permlane32_swap(__float_as_uint(b2), __float_as_uint(b2), false, false); const auto t2_ = __builtin_amdgcn_permlane32_swap((unsigned)j2, (unsigned)j2, false, false);
      const float o0 = __uint_as_float(hi ? s0_[0] : s0_[1]), o1 = __uint_as_float(hi ? s1_[0] : s1_[1]), o2 = __uint_as_float(hi ? s2_[0] : s2_[1]);
      const int p0 = (int)(hi ? t0_[0] : t0_[1]), p1 = (int)(hi ? t1_[0] : t1_[1]), p2 = (int)(hi ? t2_[0] : t2_[1]);
      if (p0 < 64) TK_INSERT(o0, p0); if (p1 < 64) TK_INSERT(o1, p1); if (p2 < 64) TK_INSERT(o2, p2); }
    __syncthreads();
    unsigned* cnt = (unsigned*)(C.ws + WS_CNT) + (size_t)(l * 8 + h) * 32 * CNT_STRIDE; unsigned* list = (unsigned*)(C.ws + WS_LIST) + (size_t)h * 32 * S_;
    unsigned r0 = 0u, r1 = 0u, r2 = 0u;
    if (hi == 0) {
        if (j0 < 64) r0 = __hip_atomic_fetch_add(hist + j0, 1u, __ATOMIC_RELAXED, __HIP_MEMORY_SCOPE_WORKGROUP);
        if (j1 < 64) r1 = __hip_atomic_fetch_add(hist + j1, 1u, __ATOMIC_RELAXED, __HIP_MEMORY_SCOPE_WORKGROUP);
        if (j2 < 64) r2 = __hip_atomic_fetch_add(hist + j2, 1u, __ATOMIC_RELAXED, __HIP_MEMORY_SCOPE_WORKGROUP); }
    __syncthreads();
    if (C.tid < qb) { const unsigned c = hist[C.tid]; basev[C.tid] = c ? atomicAdd(cnt + C.tid * CNT_STRIDE, c) : 0u; }
    __syncthreads();
    if (hi == 0) {
        if (j0 < 64) list[(size_t)j0 * S_ + basev[j0] + r0] = (unsigned)q | (1u << 16);
        if (j1 < 64) list[(size_t)j1 * S_ + basev[j1] + r1] = (unsigned)q | (2u << 16);
        if (j2 < 64) list[(size_t)j2 * S_ + basev[j2] + r2] = (unsigned)q | (3u << 16); }
    __syncthreads();
}
#undef TK_INSERT
#undef TK_BETTER
__device__ __forceinline__ void ssd_state_unit(const Ctx& C, int u) {
    const int c = u >> 5, hh = u & 31, g = hh >> 3, mi = C.wave >> 2, ni = C.wave & 3, r32 = C.lane & 31, hi = C.lane >> 5;
    const bf16* Ap = (const bf16*)(C.ws + A_XDT) + (size_t)(64 * hh + 32 * mi + r32) * S_ + 256 * c + 8 * hi;
    const bf16* Bp = (const bf16*)(C.ws + A_BT) + (size_t)(128 * g + 32 * ni + r32) * S_ + 256 * c + 8 * hi;
    const float* ac = (const float*)(C.ws + WS_ACST) + (size_t)hh * S_ + 256 * c;
    float* dte = (float*)(C.lds + C.wave * 1024);
    const f32x4 dv = *(const f32x4*)(ac + 4 * C.lane); const float aend = ac[255];
    v4u av[16], bv[16];
#pragma unroll
    for (int ks = 0; ks < 16; ++ks) { av[ks] = *(const v4u*)(Ap + 16 * ks); bv[ks] = *(const v4u*)(Bp + 16 * ks); }
    *(f32x4*)(dte + 4 * C.lane) = (f32x4){__expf(aend - dv[0]), __expf(aend - dv[1]), __expf(aend - dv[2]), __expf(aend - dv[3])};
    asm volatile("s_waitcnt lgkmcnt(0)" ::: "memory");
    f32x16 acc = {};
#pragma unroll
    for (int ks = 0; ks < 16; ++ks) { const f32x4 d0 = *(const f32x4*)(dte + 16 * ks + 8 * hi), d1 = *(const f32x4*)(dte + 16 * ks + 8 * hi + 4);
        float f[8]; UNPACK8(av[ks], f);
        f[0] *= d0[0]; f[1] *= d0[1]; f[2] *= d0[2]; f[3] *= d0[3]; f[4] *= d1[0]; f[5] *= d1[1]; f[6] *= d1[2]; f[7] *= d1[3];
        const v4u a2 = PACK8(f);
        acc = MFMA32(a2, bv[ks], acc); }
    asm volatile("s_waitcnt lgkmcnt(0)" ::: "memory");
    float* st = (float*)(C.ws + A_STATES) + ((size_t)(c * 32 + hh) * 64 + 32 * mi) * 128 + 32 * ni + r32;
#pragma unroll
    for (int r = 0; r < 16; ++r) st[(size_t)crow(r, hi) * 128] = acc[r];
}
__device__ __forceinline__ void ssd_cb_unit(const Ctx& C, int u) {
    const int c = u >> 3, g = (u >> 1) & 3, hf = u & 1, r32 = C.lane & 31, hi = C.lane >> 5;
    const bf16* XC = (const bf16*)(C.ws + A_XC); bf16* CB = (bf16*)(C.ws + A_CBM) + (size_t)(c * 4 + g) * 65536;
    for (int tt = 18 * hf + C.wave; tt < 18 * hf + 18; tt += NWAVES) { int li = 0; while ((li + 1) * (li + 2) / 2 <= tt) ++li; const int si = tt - li * (li + 1) / 2;
        const bf16* Ap = XC + (size_t)(256 * c + 32 * li + r32) * XBCW + 2560 + 128 * g + 8 * hi;
        const bf16* Bp = XC + (size_t)(256 * c + 32 * si + r32) * XBCW + 2048 + 128 * g + 8 * hi;
        f32x16 acc = {};
        v4u av[8], bv[8];
#pragma unroll
        for (int ks = 0; ks < 8; ++ks) { av[ks] = *(const v4u*)(Ap + 16 * ks); bv[ks] = *(const v4u*)(Bp + 16 * ks); }
#pragma unroll
        for (int ks = 0; ks < 8; ++ks) acc = MFMA32(av[ks], bv[ks], acc);
        bf16* o = CB + (size_t)(32 * li) * 256 + 32 * si + r32;
#pragma unroll
        for (int r = 0; r < 16; ++r) o[(size_t)crow(r, hi) * 256] = (bf16)f2bf(acc[r]); }
}
__device__ __forceinline__ void ph_select(const Ctx& C, int l) {
#ifndef REP_STATE
#define REP_STATE 1
#endif
#ifndef REP_CB
#define REP_CB 1
#endif
    for (int u = C.bid; u < 256; u += C.G) select_unit(C, l, u);
    for (int rr = 0; rr < REP_STATE; ++rr) for (int u = C.bid; u < 1024; u += C.G) ssd_state_unit(C, u);
    for (int rr = 0; rr < REP_CB; ++rr) for (int u = C.bid; u < 256; u += C.G) ssd_cb_unit(C, u);
}

__device__ __forceinline__ void ssd_recur(const Ctx& C) {
    const float* ST = (const float*)(C.ws + A_STATES); bf16* PV = (bf16*)(C.ws + A_PREV); const float* ACS = (const float*)(C.ws + WS_ACST);
    for (int e2 = C.bid * (NWAVES * 64) + C.tid; e2 < 32 * 64 * 64; e2 += C.G * NWAVES * 64) {
        const int hh = e2 >> 12, rem = e2 & 4095, p = rem >> 6, n = (rem & 63) * 2;
        f32x2 st[NCH]; float dc[NCH];
#pragma unroll
        for (int c = 0; c < NCH; ++c) { st[c] = *(const f32x2*)(ST + ((size_t)(c * 32 + hh) * 64 + p) * 128 + n); dc[c] = ACS[(size_t)hh * S_ + 256 * c + 255]; }
        float p0 = 0.f, p1 = 0.f;
#pragma unroll
        for (int c = 0; c < NCH; ++c) { const size_t off = ((size_t)(c * 32 + hh) * 64 + p) * 128 + n;
            *(unsigned*)(PV + off) = pk2(p0, p1);
            const float dec = __expf(dc[c]); p0 = dec * p0 + st[c].x; p1 = dec * p1 + st[c].y; }
    }
}
constexpr int SHM_T = 64 * 128 * 2;
#define KSWZ(row, colB) ((row) * 256 + ((colB) ^ (((row) & 7) << 4)))
__device__ __forceinline__ int v_st(int k, int c) { const int kk = (k & ~0xC) | ((k & 4) << 1) | ((k & 8) >> 1); return ((kk >> 3) * 4 + (c >> 5)) * 512 + ((kk & 7) * 32 + (c & 31)) * 2; }
__device__ __forceinline__ int v_rd_base(int lane) { return ((lane & 3) << 3) | (((lane >> 2) & 3) << 6) | (((lane >> 4) & 1) << 5) | (((lane >> 5) & 1) << 8); }
constexpr int v_rd_off(int d0, int ks, int half) { return d0 * 512 + ks * 4096 + half * 2048; }
template <int KB>
__device__ __forceinline__ void qkt(f32x16& p0, f32x16& p1, const char* K_lds, int r32, int hi, const bf16x8* qr, float cinit) {
#pragma unroll
    for (int r = 0; r < 16; ++r) { p0[r] = cinit; p1[r] = cinit; }
    const char* kb[4];
#pragma unroll
    for (int dd = 0; dd < 4; ++dd) kb[dd] = K_lds + KB * SHM_T + KSWZ(r32, (dd * 16 + hi * 8) * 2);
#pragma unroll
    for (int d0 = 0; d0 < 8; ++d0) { const char* a = kb[d0 & 3] + (d0 >> 2) * 128;
        const bf16x8 b0 = *reinterpret_cast<const bf16x8*>(a);
        const bf16x8 b1 = *reinterpret_cast<const bf16x8*>(a + 32 * 256);
        p0 = __builtin_amdgcn_mfma_f32_32x32x16_bf16(b0, qr[d0], p0, 0, 0, 0);
        p1 = __builtin_amdgcn_mfma_f32_32x32x16_bf16(b1, qr[d0], p1, 0, 0, 0); }
}
template <int VB>
__device__ __forceinline__ void pv_tile(f32x16* o, int vb0, bf16x8 pa0, bf16x8 pa1, bf16x8 pa2, bf16x8 pa3) {
#define TRRD(dst, off) asm volatile("ds_read_b64_tr_b16 %0, %1 offset:%2" : "=&v"(dst) : "v"(vb0), "i"(off) : "memory")
#define PV_D0(d0) do { s16x4 l0, l1, l2, l3, h0, h1, h2, h3; constexpr int b_ = VB * SHM_T + v_rd_off(d0, 0, 0); \
        TRRD(l0, b_); TRRD(h0, b_ + 2048); TRRD(l1, b_ + 4096); TRRD(h1, b_ + 6144); TRRD(l2, b_ + 8192); TRRD(h2, b_ + 10240); TRRD(l3, b_ + 12288); TRRD(h3, b_ + 14336); \
        asm volatile("s_waitcnt lgkmcnt(0)" ::: "memory"); __builtin_amdgcn_sched_barrier(0); \
        o[d0] = __builtin_amdgcn_mfma_f32_32x32x16_bf16(pa0, (bf16x8){l0[0], l0[1], l0[2], l0[3], h0[0], h0[1], h0[2], h0[3]}, o[d0], 0, 0, 0); \
        o[d0] = __builtin_amdgcn_mfma_f32_32x32x16_bf16(pa1, (bf16x8){l1[0], l1[1], l1[2], l1[3], h1[0], h1[1], h1[2], h1[3]}, o[d0], 0, 0, 0); \
        o[d0] = __builtin_amdgcn_mfma_f32_32x32x16_bf16(pa2, (bf16x8){l2[0], l2[1], l2[2], l2[3], h2[0], h2[1], h2[2], h2[3]}, o[d0], 0, 0, 0); \
        o[d0] = __builtin_amdgcn_mfma_f32_32x32x16_bf16(pa3, (bf16x8){l3[0], l3[1], l3[2], l3[3], h3[0], h3[1], h3[2], h3[3]}, o[d0], 0, 0, 0); } while (0)
    PV_D0(0); PV_D0(1); PV_D0(2); PV_D0(3);
#undef PV_D0
#undef TRRD
}
__device__ __forceinline__ void sm_step(f32x16& p0, f32x16& p1, float& m_reg, float& l_reg, f32x16* o, float* al_l, int r32, int hi, bf16x8& pa0, bf16x8& pa1, bf16x8& pa2, bf16x8& pa3) {
    float pmax = p0[0];
#pragma unroll
    for (int r = 1; r < 16; ++r) pmax = fmaxf(pmax, p0[r]);
#pragma unroll
    for (int r = 0; r < 16; ++r) pmax = fmaxf(pmax, p1[r]);
    { auto rr = __builtin_amdgcn_permlane32_swap(__float_as_uint(pmax), __float_as_uint(pmax), false, false); pmax = fmaxf(__uint_as_float(rr[0]), __uint_as_float(rr[1])); }
    const float mn = (pmax - m_reg <= 8.0f) ? m_reg : fmaxf(m_reg, pmax); const float alpha = __builtin_amdgcn_exp2f(m_reg - mn); m_reg = mn;
    float ps = 0.f;
#pragma unroll
    for (int r = 0; r < 16; ++r) { p0[r] = __builtin_amdgcn_exp2f(p0[r] - mn); ps += p0[r]; }
#pragma unroll
    for (int r = 0; r < 16; ++r) { p1[r] = __builtin_amdgcn_exp2f(p1[r] - mn); ps += p1[r]; }
    { auto rr = __builtin_amdgcn_permlane32_swap(__float_as_uint(ps), __float_as_uint(ps), false, false); ps = __uint_as_float(rr[0]) + __uint_as_float(rr[1]); }
    l_reg = l_reg * alpha + ps;
    if (__any(alpha < 1.f)) { if (hi == 0) al_l[r32] = alpha; asm volatile("s_waitcnt lgkmcnt(0)" ::: "memory");
#pragma unroll
        for (int d_ = 0; d_ < 4; ++d_)
#pragma unroll
            for (int r = 0; r < 16; ++r) o[d_][r] *= al_l[crow(r, hi)]; }
#define PK4(P, B_, OUT) do { unsigned a0 = cvtpk(P[B_ + 0], P[B_ + 1]), a1 = cvtpk(P[B_ + 2], P[B_ + 3]); unsigned b0 = cvtpk(P[B_ + 4], P[B_ + 5]), b1 = cvtpk(P[B_ + 6], P[B_ + 7]); \
        auto r0 = __builtin_amdgcn_permlane32_swap(a0, b0, false, false); auto r1 = __builtin_amdgcn_permlane32_swap(a1, b1, false, false); \
        v4u w = {r0[0], r1[0], r0[1], r1[1]}; OUT = __builtin_bit_cast(bf16x8, w); } while (0)
    PK4(p0, 0, pa0); PK4(p0, 8, pa1); PK4(p1, 0, pa2); PK4(p1, 8, pa3);
#undef PK4
}
__device__ __forceinline__ void attn_item(const Ctx& C, int h, int j, bool own, int k, int cnt, bool stage, int pmode) {
    const int tid = C.tid, wid = C.wave, lane = C.lane, r32 = lane & 31, hi = lane >> 5;
    char* V_lds = (char*)C.lds; char* K_lds = (char*)C.lds + 4 * SHM_T;
    float* wsf = (float*)(C.lds + SCR_OFF) + wid * 64; float* li_l = wsf; float* al_l = wsf + 32;
    int* qtab = (int*)(C.lds + SCR_OFF + 2048) + wid * 32; float* lut = (float*)(C.lds + SCR_OFF + 3072);
    bf16* ostg = (bf16*)(C.lds + SCR_OFF + 8192) + wid * 1024;
    const bf16* KN = (const bf16*)(C.ws + A_KN); const bf16* QN = (const bf16*)(C.ws + A_QN); const bf16* MIX = (const bf16*)(C.ws + A_MIX);
    int q, slot; bool valid; unsigned ent = 0u;
    if (own) { q = 256 * j + 32 * wid + r32; slot = 0; valid = true; }
    else { const int e = 256 * k + 32 * wid + r32; valid = e < cnt; ent = ((const unsigned*)(C.ws + WS_LIST))[((size_t)h * 32 + j) * S_ + (valid ? e : 0)]; q = 0; slot = 0; }
    const int sr = tid >> 4, sc = (tid & 15) * 8; const int kws = KSWZ(sr, sc * 2), vst0 = v_st(sr, sc), vst1 = v_st(32 + sr, sc);
    v4u kr[4][2], vr[4][2];
    if (pmode == 2) stage = false;
    if (stage) {
        __syncthreads();
#pragma unroll
        for (int t = 0; t < 4; ++t) { const size_t row = (size_t)(256 * j + 64 * t + sr);
            kr[t][0] = *(const v4u*)(KN + row * AW + h * 128 + sc); kr[t][1] = *(const v4u*)(KN + (row + 32) * AW + h * 128 + sc); }
#pragma unroll
        for (int t = 0; t < 4; ++t) { const size_t row = (size_t)(256 * j + 64 * t + sr);
            vr[t][0] = *(const v4u*)(MIX + row * NMIX + MC_V + h * 128 + sc); vr[t][1] = *(const v4u*)(MIX + (row + 32) * NMIX + MC_V + h * 128 + sc); }
    }
    if (!own) { q = (int)(ent & 0xffffu); slot = (int)(ent >> 16); }
    bf16x8 qr[8];
#pragma unroll
    for (int d0 = 0; d0 < 8; ++d0) qr[d0] = *reinterpret_cast<const bf16x8*>(QN + (size_t)q * AW + h * 128 + d0 * 16 + hi * 8);
    if (stage) {
#pragma unroll
        for (int t = 0; t < 4; ++t) { *(v4u*)(K_lds + t * SHM_T + kws) = kr[t][0]; *(v4u*)(K_lds + t * SHM_T + kws + 32 * 256) = kr[t][1];
            *(v4u*)(V_lds + t * SHM_T + vst0) = vr[t][0]; *(v4u*)(V_lds + t * SHM_T + vst1) = vr[t][1]; }
        if (tid < 129) lut[tid] = ((const float*)(C.ws + WS_LUT))[h * 132 + tid];
        __syncthreads();
    }
    if (!own && 256 * k + 32 * wid >= cnt) return;
    if (hi == 0) qtab[r32] = valid ? (q | (slot << 16)) : -1;
    float m_reg = -1e30f, l_reg = 0.f; f32x16 o[4] = {};
    const int vb0 = (int)(uintptr_t)V_lds + v_rd_base(lane);
    const float far = lut[128];
    const bool near = own || __any(valid && (q - (256 * j + 255) < 128));
    f32x16 pA0, pA1, pB0, pB1; bf16x8 pa0, pa1, pa2, pa3;
    const int ntile = own ? ((32 * wid + 31) / 64 + 1) : 4;
#define ATT_MB(t, P0, P1) do { \
        if (near) { const int dq = q - (256 * j + 64 * (t)) - 4 * hi; float b0_[16], b1_[16]; \
            _Pragma("unroll") for (int r = 0; r < 16; ++r) { const int cc = (r & 3) + 8 * (r >> 2); const int d0_ = dq - cc, d1_ = d0_ - 32; \
                b0_[r] = lut[d0_ < 0 ? 0 : (d0_ < 128 ? d0_ : 128)]; b1_[r] = lut[d1_ < 0 ? 0 : (d1_ < 128 ? d1_ : 128)]; } \
            _Pragma("unroll") for (int r = 0; r < 16; ++r) { const int cc = (r & 3) + 8 * (r >> 2); const int d0_ = dq - cc, d1_ = d0_ - 32; \
                P0[r] = d0_ < 0 ? -INFINITY : P0[r] + b0_[r]; P1[r] = d1_ < 0 ? -INFINITY : P1[r] + b1_[r]; } } \
        else { _Pragma("unroll") for (int r = 0; r < 16; ++r) { P0[r] += far; P1[r] += far; } } } while (0)
#define ATT_SB() __builtin_amdgcn_sched_barrier(0)
    if (pmode != 1) {
        if (pmode != 5) qkt<0>(pA0, pA1, K_lds, r32, hi, qr, 0.f); ATT_SB();
        if (ntile > 1) { if (pmode != 5) qkt<1>(pB0, pB1, K_lds, r32, hi, qr, 0.f); ATT_SB(); }
        ATT_MB(0, pA0, pA1); if (pmode != 4) sm_step(pA0, pA1, m_reg, l_reg, o, al_l, r32, hi, pa0, pa1, pa2, pa3); ATT_SB(); if (pmode != 3) pv_tile<0>(o, vb0, pa0, pa1, pa2, pa3); ATT_SB();
        if (ntile > 1) {
            if (ntile > 2) { if (pmode != 5) qkt<2>(pA0, pA1, K_lds, r32, hi, qr, 0.f); ATT_SB(); }
            ATT_MB(1, pB0, pB1); if (pmode != 4) sm_step(pB0, pB1, m_reg, l_reg, o, al_l, r32, hi, pa0, pa1, pa2, pa3); ATT_SB(); if (pmode != 3) pv_tile<1>(o, vb0, pa0, pa1, pa2, pa3); ATT_SB();
            if (ntile > 2) {
                if (ntile > 3) { if (pmode != 5) qkt<3>(pB0, pB1, K_lds, r32, hi, qr, 0.f); ATT_SB(); }
                ATT_MB(2, pA0, pA1); if (pmode != 4) sm_step(pA0, pA1, m_reg, l_reg, o, al_l, r32, hi, pa0, pa1, pa2, pa3); ATT_SB(); if (pmode != 3) pv_tile<2>(o, vb0, pa0, pa1, pa2, pa3); ATT_SB();
                if (ntile > 3) { ATT_MB(3, pB0, pB1); if (pmode != 4) sm_step(pB0, pB1, m_reg, l_reg, o, al_l, r32, hi, pa0, pa1, pa2, pa3); ATT_SB(); if (pmode != 3) pv_tile<3>(o, vb0, pa0, pa1, pa2, pa3); } } }
    }
#undef ATT_MB
#undef ATT_SB
    if (hi == 0) li_l[r32] = l_reg; asm volatile("s_waitcnt lgkmcnt(0)" ::: "memory");
    float rl[16];
#pragma unroll
    for (int r = 0; r < 16; ++r) rl[r] = __builtin_amdgcn_rcpf(li_l[crow(r, hi)]);
    bf16* PART = (bf16*)(C.ws + A_PART);
#pragma unroll
    for (int d0 = 0; d0 < 4; ++d0) {
#pragma unroll
        for (int r = 0; r < 16; ++r) ostg[crow(r, hi) * 32 + r32] = (bf16)f2bf(o[d0][r] * rl[r]);
        asm volatile("s_waitcnt lgkmcnt(0)" ::: "memory");
#pragma unroll
        for (int i = 0; i < 2; ++i) { const int id = lane + 64 * i, row = id >> 2, ch = id & 3; const int en = qtab[row];
            const v4u w = *(const v4u*)(ostg + row * 32 + ch * 8);
            if (en >= 0) *(v4u*)(PART + ((size_t)((en >> 16) & 3) * S_ + (size_t)(en & 0xffff)) * AW + h * 128 + d0 * 32 + ch * 8) = w; }
        asm volatile("s_waitcnt lgkmcnt(0)" ::: "memory"); }
    if (hi == 0 && valid) { float* ml = (float*)(C.ws + WS_ML) + (((size_t)slot * S_ + q) * 8 + h) * 2; *(f32x2*)ml = (f32x2){m_reg, l_reg}; }
}
__device__ __forceinline__ void ph_attn(const Ctx& C, int l, int pmode) {
#ifndef REP_RECUR
#define REP_RECUR 1
#endif
    for (int rr = 0; rr < REP_RECUR; ++rr) ssd_recur(C);
    int* cntL = (int*)(C.lds + SCR_OFF + 4096); int* pre = cntL + 256;
    if (C.tid < 256) { const int n = (int)__hip_atomic_load((const unsigned*)(C.ws + WS_CNT) + (size_t)(l * 256 + C.tid) * CNT_STRIDE, __ATOMIC_RELAXED, __HIP_MEMORY_SCOPE_AGENT); cntL[C.tid] = n; }
    __syncthreads();
    if (C.wave == 0) { int v[4], tot = 0;
#pragma unroll
        for (int e = 0; e < 4; ++e) { v[e] = (cntL[4 * C.lane + e] + 255) >> 8; tot += v[e]; }
        int inc = tot;
#pragma unroll
        for (int o = 1; o < 64; o <<= 1) { const int t = __shfl_up(inc, o); if (C.lane >= o) inc += t; }
        int run = inc - tot;
#pragma unroll
        for (int e = 0; e < 4; ++e) { pre[4 * C.lane + e] = run; run += v[e]; }
        if (C.lane == 63) pre[256] = run; }
    __syncthreads();
    const int T = 256 + pre[256];
    const int t0 = (int)(((long)C.bid * T) / C.G), t1 = (int)(((long)(C.bid + 1) * T) / C.G);
    int last_hj = -1;
    for (int t = t0; t < t1; ++t) {
        if (t < 256) { attn_item(C, t >> 5, t & 31, true, 0, 256, last_hj != t, pmode); last_hj = t; continue; }
        const int tt = t - 256; int lo = 0, hi = 256;
        while (hi - lo > 1) { const int mid = (lo + hi) >> 1; if (pre[mid] <= tt) lo = mid; else hi = mid; }
        const int hj = __builtin_amdgcn_readfirstlane(lo), k = tt - __builtin_amdgcn_readfirstlane(pre[lo]), n = __builtin_amdgcn_readfirstlane(cntL[lo]);
        attn_item(C, hj >> 5, hj & 31, false, k, n, last_hj != hj, pmode); last_hj = hj;
    }
    __syncthreads();
}

__device__ __forceinline__ void ssd_tile(const Ctx& C, int l, int c, int hh, int w, bf16* slot, float* ssq_row) {
    const int g = hh >> 3, r32 = C.lane & 31, hi = C.lane >> 5;
    const float* ac = (const float*)(C.ws + WS_ACST) + (size_t)hh * S_ + 256 * c;
    float* acl = (float*)(C.lds + SCR_OFF + 8192) + C.wave * 256;
    const int lrow = 32 * w + r32; const float al = ac[lrow];
    *(f32x4*)(acl + 4 * C.lane) = *(const f32x4*)(ac + 4 * C.lane);
    asm volatile("s_waitcnt lgkmcnt(0)" ::: "memory");
    f32x16 acc0 = {}, acc1 = {};
    const bf16* Ap = (const bf16*)(C.ws + A_CBM) + ((size_t)(c * 4 + g) * 256 + lrow) * 256 + 8 * hi;
    const bf16* Bp0 = (const bf16*)(C.ws + A_XDT) + (size_t)(64 * hh + r32) * S_ + 256 * c + 8 * hi; const bf16* Bp1 = Bp0 + (size_t)32 * S_;
    const int nks = 2 * w + 2;
    for (int kb = 0; kb < nks; kb += 8) { const int nb = nks - kb < 8 ? nks - kb : 8;
        v4u av[8], b0v[8], b1v[8];
#pragma unroll
        for (int i = 0; i < 8; ++i) if (i < nb) { av[i] = *(const v4u*)(Ap + 16 * (kb + i)); b0v[i] = *(const v4u*)(Bp0 + 16 * (kb + i)); b1v[i] = *(const v4u*)(Bp1 + 16 * (kb + i)); }
#pragma unroll
        for (int i = 0; i < 8; ++i) if (i < nb) { const int s0 = 16 * (kb + i) + 8 * hi; const f32x4 d0 = *(const f32x4*)(acl + s0), d1 = *(const f32x4*)(acl + s0 + 4);
            float f[8]; UNPACK8(av[i], f);
            f[0] = (s0 + 0 <= lrow) ? f[0] * __expf(al - d0[0]) : 0.f; f[1] = (s0 + 1 <= lrow) ? f[1] * __expf(al - d0[1]) : 0.f;
            f[2] = (s0 + 2 <= lrow) ? f[2] * __expf(al - d0[2]) : 0.f; f[3] = (s0 + 3 <= lrow) ? f[3] * __expf(al - d0[3]) : 0.f;
            f[4] = (s0 + 4 <= lrow) ? f[4] * __expf(al - d1[0]) : 0.f; f[5] = (s0 + 5 <= lrow) ? f[5] * __expf(al - d1[1]) : 0.f;
            f[6] = (s0 + 6 <= lrow) ? f[6] * __expf(al - d1[2]) : 0.f; f[7] = (s0 + 7 <= lrow) ? f[7] * __expf(al - d1[3]) : 0.f;
            const v4u a2 = PACK8(f);
            acc0 = MFMA32(a2, b0v[i], acc0); acc1 = MFMA32(a2, b1v[i], acc1); } }
    v4u xt[4], zt[4];
#pragma unroll
    for (int i = 0; i < 4; ++i) { const int id = C.lane + 64 * i, row = id >> 3, ch = id & 7; const size_t grow = (size_t)(256 * c + 32 * w + row);
        xt[i] = *(const v4u*)((const bf16*)(C.ws + A_XC) + grow * XBCW + 64 * hh + ch * 8); zt[i] = *(const v4u*)((const bf16*)(C.ws + A_MIX) + grow * NMIX + MC_Z + 64 * hh + ch * 8); }
    { const float ea = __expf(al);
      const bf16* Cp = (const bf16*)(C.ws + A_XC) + (size_t)(256 * c + lrow) * XBCW + 2560 + 128 * g + 8 * hi;
      const bf16* Pp0 = (const bf16*)(C.ws + A_PREV) + ((size_t)(c * 32 + hh) * 64 + r32) * 128 + 8 * hi; const bf16* Pp1 = Pp0 + 32 * 128;
#pragma unroll 1
      for (int kh = 0; kh < 2; ++kh) {
          v4u ca[4], pb0[4], pb1[4];
#pragma unroll
          for (int ks = 0; ks < 4; ++ks) { ca[ks] = *(const v4u*)(Cp + 64 * kh + 16 * ks); pb0[ks] = *(const v4u*)(Pp0 + 64 * kh + 16 * ks); pb1[ks] = *(const v4u*)(Pp1 + 64 * kh + 16 * ks); }
#pragma unroll
          for (int ks = 0; ks < 4; ++ks) { float f[8]; UNPACK8(ca[ks], f);
#pragma unroll
              for (int e = 0; e < 8; ++e) f[e] *= ea;
              const v4u a2 = PACK8(f);
              acc0 = MFMA32(a2, pb0[ks], acc0); acc1 = MFMA32(a2, pb1[ks], acc1); } } }
    const float Dh = C.in[IN_SSDD][l * 32 + hh];
#pragma unroll
    for (int i = 0; i < 4; ++i) { const int id = C.lane + 64 * i; *(v4u*)(slot + id * 8) = xt[i]; }
    asm volatile("s_waitcnt lgkmcnt(0)" ::: "memory");
    float xv0[16], xv1[16];
#pragma unroll
    for (int r = 0; r < 16; ++r) { const int rr = crow(r, hi); xv0[r] = bf2f(slot[rr * 64 + r32]); xv1[r] = bf2f(slot[rr * 64 + 32 + r32]); }
    asm volatile("s_waitcnt lgkmcnt(0)" ::: "memory");
#pragma unroll
    for (int i = 0; i < 4; ++i) { const int id = C.lane + 64 * i; *(v4u*)(slot + id * 8) = zt[i]; }
    asm volatile("s_waitcnt lgkmcnt(0)" ::: "memory");
#pragma unroll
    for (int r = 0; r < 16; ++r) { const int rr = crow(r, hi);
        const float z0 = bf2f(slot[rr * 64 + r32]), z1 = bf2f(slot[rr * 64 + 32 + r32]);
        const float y0 = (acc0[r] + Dh * xv0[r]) * silu_f(z0), y1 = (acc1[r] + Dh * xv1[r]) * silu_f(z1);
        const unsigned w2 = cvtpk(y0, y1);
        slot[rr * 64 + r32] = (bf16)(w2 & 0xffffu); slot[rr * 64 + 32 + r32] = (bf16)(w2 >> 16);
        float s2 = y0 * y0 + y1 * y1;
        s2 += __shfl_xor(s2, 1); s2 += __shfl_xor(s2, 2); s2 += __shfl_xor(s2, 4); s2 += __shfl_xor(s2, 8); s2 += __shfl_xor(s2, 16);
        if (r32 == 0) ssq_row[rr * 8] = s2; }
    asm volatile("s_waitcnt lgkmcnt(0)" ::: "memory");
}
__device__ __forceinline__ void merge_task(const bf16* PART, const float* ML, int t, f32x2 (&ml)[4], v4u (&pw)[4]) {
    const int q = t >> 7, h = (t >> 4) & 7, dc = t & 15; const int ns = 1 + ((q >> 8) < 3 ? (q >> 8) : 3);
#pragma unroll
    for (int s = 0; s < 4; ++s) { if (s < ns) { ml[s] = *(const f32x2*)(ML + (((size_t)s * S_ + q) * 8 + h) * 2); pw[s] = *(const v4u*)(PART + ((size_t)s * S_ + q) * AW + h * 128 + dc * 8); }
        else { ml[s] = (f32x2){-1e30f, 0.f}; pw[s] = (v4u){0u, 0u, 0u, 0u}; } }
}
__device__ __forceinline__ void merge_finish(bf16* Y, int t, const f32x2 (&ml)[4], const v4u (&pw)[4]) {
    const int q = t >> 7, h = (t >> 4) & 7, dc = t & 15;
    const float M = fmaxf(fmaxf(ml[0].x, ml[1].x), fmaxf(ml[2].x, ml[3].x));
    float o[8], W = 0.f;
#pragma unroll
    for (int e = 0; e < 8; ++e) o[e] = 0.f;
#pragma unroll
    for (int s = 0; s < 4; ++s) { const float wgt = __builtin_amdgcn_exp2f(ml[s].x - M) * ml[s].y; W += wgt; float f[8]; UNPACK8(pw[s], f);
#pragma unroll
        for (int e = 0; e < 8; ++e) o[e] += wgt * f[e]; }
    const float rw = 1.0f / W;
#pragma unroll
    for (int e = 0; e < 8; ++e) o[e] *= rw;
    *(v4u*)(Y + (size_t)q * YCAT_LD + h * 128 + dc * 8) = PACK8(o);
}
__device__ __forceinline__ void attn_merge(const Ctx& C) {
    const bf16* PART = (const bf16*)(C.ws + A_PART); const float* ML = (const float*)(C.ws + WS_ML); bf16* Y = (bf16*)(C.ws + A_YCAT) + YC_ATTN;
    const int stride = C.G * NWAVES * 64;
    for (int t = C.bid * (NWAVES * 64) + C.tid; t < S_ * 128; t += 4 * stride) {
        f32x2 mlA[4], mlB[4], mlC[4], mlD[4]; v4u pwA[4], pwB[4], pwC[4], pwD[4]; const int tB = t + stride, tC = t + 2 * stride, tD = t + 3 * stride;
        const bool hasB = tB < S_ * 128, hasC = tC < S_ * 128, hasD = tD < S_ * 128;
        merge_task(PART, ML, t, mlA, pwA); if (hasB) merge_task(PART, ML, tB, mlB, pwB); if (hasC) merge_task(PART, ML, tC, mlC, pwC); if (hasD) merge_task(PART, ML, tD, mlD, pwD);
        merge_finish(Y, t, mlA, pwA); if (hasB) merge_finish(Y, tB, mlB, pwB); if (hasC) merge_finish(Y, tC, mlC, pwC); if (hasD) merge_finish(Y, tD, mlD, pwD);
    }
}
__device__ __forceinline__ void ph_ssd_out(const Ctx& C, int l) {
    float* ssq = (float*)(C.lds + SCR_OFF); float* rstdL = ssq + 1024;
    const int r32 = C.lane & 31, hi = C.lane >> 5;
    for (int u = C.bid; u < 256; u += C.G) { const int c = u >> 3, g = (u >> 1) & 3, hf = u & 1, hh = 8 * g + C.wave;
        bf16* slots = (bf16*)(C.lds + C.wave * 16384);
#pragma unroll 1
        for (int i = 0; i < 4; ++i) { const int rt = hf ? (i == 0 ? 1 : i == 1 ? 2 : i == 2 ? 5 : 6) : (i == 0 ? 0 : i == 1 ? 3 : i == 2 ? 4 : 7);
            ssd_tile(C, l, c, hh, rt, slots + i * 2048, ssq + i * 256 + C.wave); }
        __syncthreads();
        if (C.tid < 128) { const f32x4 a = *(const f32x4*)(ssq + C.tid * 8), b = *(const f32x4*)(ssq + C.tid * 8 + 4);
            rstdL[C.tid] = rsqrtf((((a[0] + a[1]) + (a[2] + a[3])) + ((b[0] + b[1]) + (b[2] + b[3]))) * (1.0f / 512.0f) + EPS); }
        __syncthreads();
        bf16* YS = (bf16*)(C.ws + A_YCAT) + YC_SSD;
#pragma unroll 1
        for (int i = 0; i < 4; ++i) { const int rt = hf ? (i == 0 ? 1 : i == 1 ? 2 : i == 2 ? 5 : 6) : (i == 0 ? 0 : i == 1 ? 3 : i == 2 ? 4 : 7); bf16* yt = slots + i * 2048;
#pragma unroll
            for (int r = 0; r < 16; ++r) { const int rr = crow(r, hi); const float rs = rstdL[i * 32 + rr];
                const unsigned w2 = cvtpk(bf2f(yt[rr * 64 + r32]) * rs, bf2f(yt[rr * 64 + 32 + r32]) * rs);
                yt[rr * 64 + r32] = (bf16)(w2 & 0xffffu); yt[rr * 64 + 32 + r32] = (bf16)(w2 >> 16); }
            asm volatile("s_waitcnt lgkmcnt(0)" ::: "memory");
#pragma unroll
            for (int k = 0; k < 4; ++k) { const int id = C.lane + 64 * k, row = id >> 3, ch = id & 7;
                *(v4u*)(YS + (size_t)(256 * c + 32 * rt + row) * YCAT_LD + 64 * hh + ch * 8) = *(const v4u*)(yt + id * 8); } }
        __syncthreads();
    }
    attn_merge(C);
}

struct Args { const float* in[21]; float* out; unsigned char* ws; int pad0, pad1; };
static_assert(sizeof(Args) == 21 * 8 + 8 + 8 + 8, "Args has no padding");
typedef __attribute__((address_space(4))) const Args* CArgsP;
#define MKCTX() Ctx C; { CArgsP ap_ = (CArgsP)__builtin_amdgcn_kernarg_segment_ptr(); asm volatile("" : "+s"(ap_)); \
        C.lds = lds; C.tid = threadIdx.x; asm volatile("" : "+v"(C.tid)); C.lane = C.tid & 63; C.wave = __builtin_amdgcn_readfirstlane(C.tid >> 6); C.G = gridDim.x; C.bid = blockIdx.x; \
        _Pragma("unroll") for (int i_ = 0; i_ < 21; ++i_) C.in[i_] = (const float*)(const GAS float*)ap_->in[i_]; C.out = (float*)(GAS float*)ap_->out; C.ws = (unsigned char*)(GAS unsigned char*)ap_->ws; }
#define LAYER_PTRS() unsigned char* wl = C.ws + WS_W + (size_t)l * LAYER_W; const float* ada = (const float*)(C.ws + WS_ADA) + l * NADA; float* rowss = (float*)(C.ws + WS_RSP); bf16* XB = (bf16*)(C.ws + WS_XB); unsigned char* XB8 = C.ws + WS_XB8; (void)XB8; (void)wl; (void)ada; (void)rowss; (void)XB
#ifndef PHMASK
#define PHMASK 0xFFFF
#endif
#define KON(kd) (((PHMASK) >> (kd)) & 1)
#ifndef REP_CONV
#define REP_CONV 1
#endif
#define SEAM() xcd_barrier(bar)
#define RS_IN (STREAM_BF16 ? 8 : 0)
#define RS_F32 (STREAM_BF16 ? 0 : 16)
template <int l> __device__ __forceinline__ void layer_body(unsigned char* lds, LAS unsigned char* ldsl, const XcdBarrier& bar) {
    if (KON(2)) { MKCTX(); LAYER_PTRS(); pg8::Gemm g{(const bf16*)XB, (const bf16*)(wl + W_IN), S_, FF2, DM}; pg8::StaticOrder S; S.init(S_, FF2, C.G, C.bid);
        pg8::EpiSwiGLU<false> E{(bf16*)(C.ws + A_HID), (const float*)(C.ws + WS_BIASIN) + (size_t)(l * 2 + 0) * FF2, rowss, FF, ldsl};
        pg8::gemm_phase<pg8::EpiSwiGLU<false>, pg8::StaticOrder, true, true, false>(ldsl, g, S, E);
        { int iw, niw; tail_waves(C, (S_ / 256) * (FF2 / 256), iw, niw); if (niw) convert_tail(C, l, 0, iw, niw); } }
    SEAM();
    if (KON(3)) { MKCTX(); LAYER_PTRS(); pg8::Gemm g{(const bf16*)(C.ws + A_HID), (const bf16*)(wl + W_OUT), S_, DM, FF}; pg8::StaticOrder S; S.init(S_, DM, C.G, C.bid);
        pg8::EpiResid E{l == 0 ? C.in[IN_X] : C.out, C.out, XB, XB8, ada + (0 * 3 + 2) * 2048, rowss, 0.5f, (MIX_GATE_FP8 && l == 1 ? 3 : 1) | 4 | RS_IN | RS_F32};
        pg8::gemm_phase<pg8::EpiResid, pg8::StaticOrder, true, true, false>(ldsl, g, S, E); }
    SEAM();
    constexpr bool G8 = MIX_GATE_FP8 && l == 1;
    if (KON(4)) { MKCTX(); LAYER_PTRS(); constexpr int NB = G8 ? MC_GA : NMIX;
        { pg8::Gemm g{XB, (const bf16*)(wl + W_MIX), S_, NB, DM}; pg8::StaticOrder S; S.init(S_, NB, C.G, C.bid);
          pg8::EpiMix E{(bf16*)(C.ws + A_MIX), (const float*)(C.ws + WS_BIASMIX) + (size_t)l * NMIX, rowss, NMIX, MC_GA / 256, 0, ldsl};
          pg8::gemm_phase<pg8::EpiMix, pg8::StaticOrder, true, true>(ldsl, g, S, E); }
        { int iw, niw; tail_waves(C, (S_ / 256) * (NB / 256), iw, niw); if (niw) convert_tail(C, l, 1, iw, niw); }
        if constexpr (G8) { __syncthreads();
          pg8::Gemm g{(const bf16*)XB8, (const bf16*)(wl + W_MIX + (size_t)MC_GA * DM * 2), S_, NMIX - MC_GA, DM / 2}; pg8::StaticOrder S; S.init(S_, NMIX - MC_GA, C.G, C.bid);
          pg8::EpiMix E{(bf16*)(C.ws + A_MIX), (const float*)(C.ws + WS_BIASMIX) + (size_t)l * NMIX, rowss, NMIX, 0, MC_GA, ldsl};
          pg8::gemm_phase<pg8::EpiMix, pg8::StaticOrder, true, true, true>(ldsl, g, S, E); } }
    SEAM();
    if (KON(5)) { { MKCTX(); ph_prep_qk(C, l); } { MKCTX(); ph_prep_ssd(C, l); } { MKCTX(); ph_prep_conv(C, l); } } SEAM();
    if (KON(6)) { MKCTX(); ph_select(C, l); } SEAM();
    if (KON(7)) { MKCTX(); ph_attn(C, l, 0); } SEAM();
    if (KON(8)) { MKCTX(); ph_ssd_out(C, l); } SEAM();
    if (KON(10)) { MKCTX(); LAYER_PTRS(); pg8::StaticOrder S; S.init(S_, DM, C.G, C.bid); const bf16* MIX = (const bf16*)(C.ws + A_MIX);
        pg8::Gemm g{(const bf16*)(C.ws + A_YCAT), (const bf16*)(wl + W_BA), S_, DM, YCAT_LD}; pg8::EpiBrCat E{MIX + MC_GA, MIX + MC_GS, MIX + MC_GC, NMIX, (bf16*)(C.ws + A_MRG)};
        pg8::gemm_phase<pg8::EpiBrCat, pg8::StaticOrder, true, true>(ldsl, g, S, E); }
    SEAM();
    constexpr bool F8 = LAST_FFN_FP8 && l == 1;
    if (KON(11)) { MKCTX(); LAYER_PTRS(); pg8::Gemm g{(const bf16*)(C.ws + A_MRG), (const bf16*)(wl + W_MO), S_, DM, DM}; pg8::StaticOrder S; S.init(S_, DM, C.G, C.bid);
        pg8::EpiResid E{C.out, C.out, XB, XB8, ada + (1 * 3 + 2) * 2048, rowss, 1.0f, (F8 ? (STREAM_BF16 ? 3 : 2) : 1) | 4 | RS_IN | RS_F32};
        pg8::gemm_phase<pg8::EpiResid, pg8::StaticOrder, true, true>(ldsl, g, S, E); }
    SEAM();
    if (KON(2)) { MKCTX(); LAYER_PTRS(); pg8::Gemm g{F8 ? (const bf16*)XB8 : (const bf16*)XB, (const bf16*)(wl + W_IN + W_IN_SZ), S_, FF2, F8 ? DM / 2 : DM}; pg8::StaticOrder S; S.init(S_, FF2, C.G, C.bid);
        pg8::EpiSwiGLU<F8> E{(bf16*)(C.ws + A_HID), (const float*)(C.ws + WS_BIASIN) + (size_t)(l * 2 + 1) * FF2, rowss, FF, ldsl};
        pg8::gemm_phase<pg8::EpiSwiGLU<F8>, pg8::StaticOrder, true, true, F8>(ldsl, g, S, E);
        { int iw, niw; tail_waves(C, (S_ / 256) * (FF2 / 256), iw, niw); if (niw) convert_tail(C, l, 2, iw, niw); } }
    SEAM();
    if (KON(3)) { MKCTX(); LAYER_PTRS(); pg8::Gemm g{(const bf16*)(C.ws + A_HID), (const bf16*)(wl + W_OUT + W_OUT_SZ), S_, DM, F8 ? FF / 2 : FF}; pg8::StaticOrder S; S.init(S_, DM, C.G, C.bid);
        pg8::EpiResid E{C.out, C.out, XB, XB8, ada + (2 * 3 + 2) * 2048, rowss, 0.5f, (l == 0 ? (1 | 4 | RS_F32) : 16) | RS_IN};
        pg8::gemm_phase<pg8::EpiResid, pg8::StaticOrder, true, true, F8>(ldsl, g, S, E); }
}
__global__ void __launch_bounds__(NWAVES * 64, 2) hybrid_fwd(Args args) {
    extern __shared__ __attribute__((aligned(16))) unsigned char lds[];
    const int tid0 = threadIdx.x;
    LAS unsigned char* ldsl = (LAS unsigned char*)lds;
    volatile LAS unsigned* MISC = (volatile LAS unsigned*)(ldsl + MISC_OFF);
    for (int u = tid0; u < 64; u += NWAVES * 64) ((LAS unsigned*)(ldsl + MISC_OFF))[u] = 0u;
    __syncthreads();
    gu32* ctl = (gu32*)(args.ws + WS_CTL);
    XcdBarrier bar = xcd_barrier_post((unsigned*)(ctl + CW_BAR), MISC + 8);
    if (KON(0)) { MKCTX(); ph_ada(C); } SEAM();
    if (KON(1)) { MKCTX(); ph_convert(C); } SEAM();
    if (REP_CONV > 1) { { MKCTX(); ph_convert(C); } SEAM(); }
    layer_body<0>(lds, ldsl, bar);
    SEAM();
    layer_body<1>(lds, ldsl, bar);
}

extern "C" void kernel_launch(void* const* d_in, const int* in_sizes, int n_in, void* d_out, int out_size, void* d_ws, size_t ws_size, hipStream_t stream) {
    static int grid = 0;
    if (grid == 0) {
        if (n_in != 21 || in_sizes[0] != S_ * DM || out_size != S_ * DM || ws_size < WS_END) {
            fprintf(stderr, "kernel_launch: unexpected shapes (n_in %d, in0 %d, out %d, ws %zu, need %zu); nothing launched\n", n_in, n_in > 0 ? in_sizes[0] : -1, out_size, ws_size, (size_t)WS_END); grid = -1; return; }
        int dev = 0, cus = 0, per_cu = 0;
        if (hipGetDevice(&dev) != hipSuccess || hipDeviceGetAttribute(&cus, hipDeviceAttributeMultiprocessorCount, dev) != hipSuccess || cus <= 0) { fprintf(stderr, "kernel_launch: device query failed\n"); grid = -1; return; }
        if (hipFuncSetAttribute((const void*)hybrid_fwd, hipFuncAttributeMaxDynamicSharedMemorySize, LDS_BYTES) != hipSuccess) { fprintf(stderr, "kernel_launch: hipFuncSetAttribute failed\n"); grid = -1; return; }
        if (hipOccupancyMaxActiveBlocksPerMultiprocessor(&per_cu, (const void*)hybrid_fwd, NWAVES * 64, LDS_BYTES) != hipSuccess || per_cu < 1)
            fprintf(stderr, "kernel_launch: note: occupancy query reports %d workgroups per CU\n", per_cu);
        (void)hipGetLastError();
        grid = cus;
    }
    if (grid < 0) return;
    if (hipMemsetAsync((char*)d_ws, 0, ZERO_BYTES, stream) != hipSuccess) { fprintf(stderr, "kernel_launch: memset failed\n"); return; }
    Args a{};
    for (int i = 0; i < 21; ++i) a.in[i] = (const float*)d_in[i];
    a.out = (float*)d_out; a.ws = (unsigned char*)d_ws;
    hipLaunchKernelGGL(hybrid_fwd, dim3(grid), dim3(NWAVES * 64), LDS_BYTES, stream, a);
    const hipError_t le = hipPeekAtLastError();
    if (le != hipSuccess) fprintf(stderr, "kernel_launch: launch failed: %s\n", hipGetErrorName(le));
}
```
